# Optimizing an MI355X kernel written in HIP

```python
import math
import jax, jax.numpy as jnp
from jax import lax
import numpy as np

D_MODEL = 1024
BATCH = 4
SEQ = 8192
DEPTH = 4

N_MEM = 256
POOL_WIDTH = 256
POOL_GROUPS = 4
POOL_GROUP_DIM = POOL_WIDTH // POOL_GROUPS
POOL_WINDOWS = (2, 4, 8, 16)
DA_HEADS = 4
DA_HEAD_DIM = 64
DA_V_DIM = 2 * DA_HEAD_DIM
DA_WIDTH = DA_HEADS * DA_V_DIM
CA_HEADS = 4
CA_HEAD_DIM = 64
CA_WIDTH = CA_HEADS * CA_HEAD_DIM
IN_SPLITS = (POOL_WIDTH, POOL_WIDTH + DA_WIDTH, POOL_WIDTH + 2 * DA_WIDTH, POOL_WIDTH + 3 * DA_WIDTH)
IN_WIDTH = POOL_WIDTH + 3 * DA_WIDTH + CA_WIDTH
N_BRANCH = 3
D_FF = 2816
ROPE_THETA = 500000.0
ROPE_DIM = DA_HEAD_DIM // 4
Q_BLOCK = 128
NORM_EPS = 1e-6
LAMBDA_STD = 0.1

kernel_name = "hybrid_pool_diffattn_memxattn_macaron_encoder"


def rms_norm(x, g):
    xf = x.astype(jnp.float32)
    xf = xf * lax.rsqrt(jnp.mean(xf * xf, axis=-1, keepdims=True) + NORM_EPS)
    return (xf * g.astype(jnp.float32)).astype(x.dtype)


def swiglu(h, w_up, w_down):
    a, b = jnp.split(h @ w_up, 2, axis=-1)
    return (jax.nn.silu(a) * b) @ w_down


def rope_tables(positions):
    inv = ROPE_THETA ** (-jnp.arange(0, ROPE_DIM, 2, dtype=jnp.float32) / ROPE_DIM)
    ang = positions.astype(jnp.float32)[..., None] * inv
    return jnp.cos(ang), jnp.sin(ang)


def apply_partial_rope(x, cos, sin):
    half = ROPE_DIM // 2
    x1, x2, xp = x[..., :half], x[..., half:ROPE_DIM], x[..., ROPE_DIM:]
    c = cos[:, :, None, None, :].astype(x.dtype)
    s = sin[:, :, None, None, :].astype(x.dtype)
    return jnp.concatenate([x1 * c - x2 * s, x2 * c + x1 * s, xp], axis=-1)


def multiscale_pool(u, w_group, scale):
    B, S, _ = u.shape
    uf = u.astype(jnp.float32)
    csum = jnp.concatenate([jnp.zeros_like(uf[:, :1]), jnp.cumsum(uf, axis=1)], axis=1)
    pos = jnp.arange(S)
    outs = []
    for gi, w in enumerate(POOL_WINDOWS):
        lo = jnp.clip(pos - w // 2, 0, S)
        hi = jnp.clip(pos + w // 2, 0, S)
        sl = slice(gi * POOL_GROUP_DIM, (gi + 1) * POOL_GROUP_DIM)
        cg = csum[:, :, sl]
        cnt = (hi - lo).astype(jnp.float32)[None, :, None]
        outs.append((cg[:, hi] - cg[:, lo]) / cnt - uf[:, :, sl])
    pooled = jnp.stack(outs, axis=2).astype(u.dtype)
    mixed = jnp.einsum('bsgc,gcd->bsgd', pooled, w_group)
    return mixed.reshape(B, S, POOL_WIDTH) * scale


def diff_attention(q, k, v, lam):
    B, S = q.shape[:2]
    nblk = S // Q_BLOCK
    qb = q.reshape(B, nblk, Q_BLOCK, DA_HEADS, 2, DA_HEAD_DIM).transpose(1, 0, 2, 3, 4, 5)
    scale = DA_HEAD_DIM ** -0.5

    def block(qi):
        s = jnp.einsum('bqhcd,bkhcd->bhcqk', qi, k, preferred_element_type=jnp.float32) * scale
        p = jax.nn.softmax(s, axis=-1)
        a = p[:, :, 0] - lam * p[:, :, 1]
        return jnp.einsum('bhqk,bkhe->bqhe', a.astype(v.dtype), v)

    o = lax.map(block, qb)
    return o.transpose(1, 0, 2, 3, 4).reshape(B, S, DA_HEADS, DA_V_DIM)


def memory_cross_attention(q, kv):
    B, M, _ = kv.shape
    k, v = jnp.split(kv, 2, axis=-1)
    k = k.reshape(B, M, CA_HEADS, CA_HEAD_DIM)
    v = v.reshape(B, M, CA_HEADS, CA_HEAD_DIM)
    s = jnp.einsum('bshd,bmhd->bhsm', q, k, preferred_element_type=jnp.float32) * (CA_HEAD_DIM ** -0.5)
    p = jax.nn.softmax(s, axis=-1).astype(v.dtype)
    return jnp.einsum('bhsm,bmhd->bshd', p, v)


def setup_inputs(seed: int = 0) -> dict:
    key = jax.random.key(seed)
    ks = jax.random.split(key, 32)
    f32 = jnp.float32

    def nrm(k, shape, fan_in):
        return jax.random.normal(k, shape, f32) * (fan_in ** -0.5)

    def gain(k, shape):
        return 1.0 + 0.05 * jax.random.normal(k, shape, f32)

    L, D = DEPTH, D_MODEL
    return {
        "x": jax.random.normal(ks[0], (BATCH, SEQ, D), f32),
        "mem": jax.random.normal(ks[1], (BATCH, N_MEM, D), f32),
        "positions": jnp.broadcast_to(jnp.arange(SEQ, dtype=jnp.int32), (BATCH, SEQ)),
        "ffn1_pre_g": gain(ks[2], (L, D)),
        "ffn1_w_up": nrm(ks[3], (L, D, 2 * D_FF), D),
        "ffn1_w_down": nrm(ks[4], (L, D_FF, D), D_FF),
        "ffn1_post_g": gain(ks[5], (L, D)),
        "mix_pre_g": gain(ks[6], (L, D)),
        "w_in": nrm(ks[7], (L, D, IN_WIDTH), D),
        "pool_w": nrm(ks[8], (L, POOL_GROUPS, POOL_GROUP_DIM, POOL_GROUP_DIM), POOL_GROUP_DIM),
        "pool_scale": gain(ks[9], (L, POOL_WIDTH)),
        "da_lambda_q1": LAMBDA_STD * jax.random.normal(ks[10], (L, DA_HEAD_DIM), f32),
        "da_lambda_k1": LAMBDA_STD * jax.random.normal(ks[11], (L, DA_HEAD_DIM), f32),
        "da_lambda_q2": LAMBDA_STD * jax.random.normal(ks[12], (L, DA_HEAD_DIM), f32),
        "da_lambda_k2": LAMBDA_STD * jax.random.normal(ks[13], (L, DA_HEAD_DIM), f32),
        "da_subln_g": gain(ks[14], (L, DA_V_DIM)),
        "mem_norm_g": gain(ks[15], (L, D)),
        "w_mem_kv": nrm(ks[16], (L, D, 2 * CA_WIDTH), D),
        "w_gate": nrm(ks[17], (L, D, N_BRANCH * D), D),
        "b_gate": 0.01 * jax.random.normal(ks[18], (L, N_BRANCH * D), f32),
        "w_br_pool": nrm(ks[19], (L, POOL_WIDTH, D), POOL_WIDTH),
        "w_br_da": nrm(ks[20], (L, DA_WIDTH, D), DA_WIDTH),
        "w_br_ca": nrm(ks[21], (L, CA_WIDTH, D), CA_WIDTH),
        "w_out": nrm(ks[22], (L, D, D), D),
        "mix_post_g": gain(ks[23], (L, D)),
        "ffn2_pre_g": gain(ks[24], (L, D)),
        "ffn2_w_up": nrm(ks[25], (L, D, 2 * D_FF), D),
        "ffn2_w_down": nrm(ks[26], (L, D_FF, D), D_FF),
        "ffn2_post_g": gain(ks[27], (L, D)),
    }


def reference(x, mem, positions, ffn1_pre_g, ffn1_w_up, ffn1_w_down, ffn1_post_g,
              mix_pre_g, w_in, pool_w, pool_scale, da_lambda_q1, da_lambda_k1,
              da_lambda_q2, da_lambda_k2, da_subln_g, mem_norm_g, w_mem_kv,
              w_gate, b_gate, w_br_pool, w_br_da, w_br_ca, w_out, mix_post_g,
              ffn2_pre_g, ffn2_w_up, ffn2_w_down, ffn2_post_g):
    B, S, _ = x.shape
    cos, sin = rope_tables(positions)
    f32 = jnp.float32
    for l in range(DEPTH):
        lam_init = 0.8 - 0.6 * math.exp(-0.3 * l)

        h = rms_norm(x, ffn1_pre_g[l])
        x = x + 0.5 * rms_norm(swiglu(h, ffn1_w_up[l], ffn1_w_down[l]), ffn1_post_g[l])

        h = rms_norm(x, mix_pre_g[l])
        u_pool, q_da, k_da, v_da, q_ca = jnp.split(h @ w_in[l], IN_SPLITS, axis=-1)

        y_pool = multiscale_pool(u_pool, pool_w[l], pool_scale[l])

        q = apply_partial_rope(q_da.reshape(B, S, DA_HEADS, 2, DA_HEAD_DIM), cos, sin)
        k = apply_partial_rope(k_da.reshape(B, S, DA_HEADS, 2, DA_HEAD_DIM), cos, sin)
        v = v_da.reshape(B, S, DA_HEADS, DA_V_DIM)
        lam = (jnp.exp(jnp.sum(da_lambda_q1[l].astype(f32) * da_lambda_k1[l].astype(f32)))
               - jnp.exp(jnp.sum(da_lambda_q2[l].astype(f32) * da_lambda_k2[l].astype(f32)))
               + lam_init)
        o = diff_attention(q, k, v, lam)
        y_da = (rms_norm(o, da_subln_g[l]) * (1.0 - lam_init)).reshape(B, S, DA_WIDTH)

        kv = rms_norm(mem, mem_norm_g[l]) @ w_mem_kv[l]
        y_ca = memory_cross_attention(q_ca.reshape(B, S, CA_HEADS, CA_HEAD_DIM), kv).reshape(B, S, CA_WIDTH)

        g_pool, g_da, g_ca = jnp.split(jax.nn.sigmoid(h @ w_gate[l] + b_gate[l]), N_BRANCH, axis=-1)
        merged = (g_pool * (y_pool @ w_br_pool[l])
                  + g_da * (y_da @ w_br_da[l])
                  + g_ca * (y_ca @ w_br_ca[l]))
        x = x + rms_norm(merged @ w_out[l], mix_post_g[l])

        h = rms_norm(x, ffn2_pre_g[l])
        x = x + 0.5 * rms_norm(swiglu(h, ffn2_w_up[l], ffn2_w_down[l]), ffn2_post_g[l])
    return x
```

```cpp
#include <hip/hip_runtime.h>
#include <hip/hip_cooperative_groups.h>
#include <cstdio>
#include <cstdint>
namespace cg = cooperative_groups;
#ifndef EN_G1
#define EN_G1 1
#endif
#ifndef EN_GS
#define EN_GS 1
#endif
#ifndef EN_GR
#define EN_GR 1
#endif
#ifndef EN_GG
#define EN_GG 1
#endif
#ifndef EN_GEMM
#define EN_GEMM 1
#endif
#ifndef EN_DA
#define EN_DA 1
#endif
#ifndef EN_CA
#define EN_CA 1
#endif
#ifndef EN_POOL
#define EN_POOL 1
#endif
#ifndef EN_NORM
#define EN_NORM 1
#endif
#ifndef EN_CONV
#define EN_CONV 1
#endif

#define LAS __attribute__((address_space(3)))
typedef unsigned short bf16_t;
typedef short bf16x8 __attribute__((ext_vector_type(8)));
typedef short s16x4 __attribute__((ext_vector_type(4)));
typedef float f32x4 __attribute__((ext_vector_type(4)));
typedef float f32x2 __attribute__((ext_vector_type(2)));
typedef float f32x16 __attribute__((ext_vector_type(16)));
typedef unsigned u32x4 __attribute__((ext_vector_type(4)));
typedef unsigned u32x2 __attribute__((ext_vector_type(2)));

constexpr int NTOK = 32768, DM = 1024, SEQ = 8192, NBATCH = 4, FF = 2816, NUP = 5632, INW = 2048, NMEM = 256, DEPTH = 4;
constexpr float NORM_EPS = 1e-6f;
constexpr int NWAVES = 8, NTHR = 512;

constexpr size_t MiB = 1u << 20;
constexpr size_t WS_XCNT = 64 * 1024;
constexpr size_t WS_XSLOT = 6 * MiB;
constexpr size_t WS_RSTD = 7 * MiB;
constexpr size_t WS_ROPE = 1 * MiB;
constexpr size_t WS_MEMN = 3 * MiB;
constexpr size_t WS_KVM  = 5 * MiB;
constexpr size_t WS_W    = 8 * MiB;
constexpr size_t W_UP1 = 0, W_DN1 = W_UP1 + (size_t)NUP * DM * 2, W_IN = W_DN1 + (size_t)DM * FF * 2, W_GATE = W_IN + (size_t)INW * DM * 2,
                 W_BRP = W_GATE + (size_t)3072 * DM * 2, W_BRD = W_BRP + (size_t)DM * 256 * 2, W_BRC = W_BRD + (size_t)DM * 512 * 2,
                 W_OUT3 = W_BRC + (size_t)DM * 256 * 2, W_UP2 = W_OUT3 + (size_t)DM * 3072 * 2, W_DN2 = W_UP2 + (size_t)NUP * DM * 2,
                 W_KV = W_DN2 + (size_t)DM * FF * 2, W_POOL = W_KV + (size_t)512 * DM * 2, W_END = W_POOL + 4 * 64 * 64 * 2;
static_assert(WS_W + W_END <= 64 * MiB, "weights region");
constexpr size_t WS_H   = 64 * MiB;
constexpr size_t WS_Y   = 128 * MiB;
constexpr size_t WS_T1  = 192 * MiB;
constexpr size_t WS_BIG = 256 * MiB;
constexpr size_t WS_OT  = WS_BIG + 128 * MiB;
constexpr size_t WS_MRG = 448 * MiB;
constexpr size_t WS_TOTAL = 512 * MiB;

typedef __bf16 bf16x2_cv __attribute__((ext_vector_type(2)));
__device__ __forceinline__ unsigned cvt_pk_bf16(float lo, float hi) { f32x2 v = {lo, hi}; bf16x2_cv b = __builtin_convertvector(v, bf16x2_cv); return __builtin_bit_cast(unsigned, b); }
__device__ __forceinline__ float bf_lo(unsigned u) { return __uint_as_float(u << 16); }
__device__ __forceinline__ float bf_hi(unsigned u) { return __uint_as_float(u & 0xffff0000u); }
__device__ __forceinline__ float wave_sum(float v) {
#pragma unroll
    for (int o = 1; o < 64; o <<= 1) v += __shfl_xor(v, o);
    return v;
}
__device__ __forceinline__ float sigmoidf_fast(float x) { return __builtin_amdgcn_rcpf(1.0f + __builtin_amdgcn_exp2f(-1.4426950408889634f * x)); }

namespace pg8 {
constexpr int BM = 256, BK = 64, HALF = 128, HTB = HALF * BK * 2, STAGE_BYTES = 8 * HTB, NXCD = 8, WGM = 8;
__host__ __device__ __forceinline__ int lds_byte(int r, int c) { const int st = (r >> 4) * 2 + (c >> 5), rr = r & 15, cc = c & 31, ob = rr * 64 + cc * 2; return st * 1024 + (ob ^ (((ob >> 9) & 1) << 5)); }
__host__ __device__ __forceinline__ void stage_rc(int b, int& R, int& C) { const int st = b / 1024, sb = b % 1024, swz = sb ^ (((sb >> 9) & 1) << 5); R = (st >> 1) * 16 + swz / 64; C = (st & 1) * 32 + (swz % 64) / 2; }
__host__ __device__ __forceinline__ int perm32(int rho) { const int n = rho >> 4, i = rho & 15; return 8 * (i >> 2) + 4 * n + (i & 3); }

struct Unit { int pm, pn; };
struct Gemm { const bf16_t* A; const bf16_t* Bt; int lda, ldb, M, N, K; };

struct StaticOrder {
    int nM, nN, nwg, G, c;
    __device__ void init(int M, int N, int G_, int c_) { nM = M / BM; nN = N / BM; nwg = nM * nN; G = G_; c = c_; }
    __device__ bool next(int i, Unit& u) const {
        const long L = (long)i * G + c; if (L >= nwg) return false;
        int wgid = (int)L; { const int q = nwg / NXCD, r = nwg % NXCD, xcd = wgid % NXCD, off = wgid / NXCD; wgid = (xcd < r ? xcd * (q + 1) : r * (q + 1) + (xcd - r) * q) + off; }
        const int nig = WGM * nN, gid = wgid / nig, fm = gid * WGM, gsz = (nM - fm) < WGM ? (nM - fm) : WGM;
        u.pm = fm + ((wgid % nig) % gsz); u.pn = (wgid % nig) / gsz; return true;
    }
};

struct EpiStore {
    static constexpr bool FUSED = false;
    bf16_t* O; int ldc;
    __device__ __forceinline__ void prefetch(const Unit&, int, int, float (&)[2][4]) const {}
    __device__ __forceinline__ void operator()(const f32x4 (&acc)[2][2][4][2], const Unit& u, int wr, int wc, int fr, int fq, const float (&)[2][4]) const {
        const int row0 = u.pm * BM + wr * 64 + fr, col0 = u.pn * BM + wc * 32 + 8 * fq;
#pragma unroll
        for (int ai = 0; ai < 2; ++ai)
#pragma unroll
            for (int m = 0; m < 4; ++m) { bf16_t* rowp = O + (size_t)(row0 + ai * HALF + m * 16) * ldc + col0;
#pragma unroll
                for (int bj = 0; bj < 2; ++bj) { const f32x4 v0 = acc[ai][bj][m][0], v1 = acc[ai][bj][m][1];
                    u32x4 w; w.x = cvt_pk_bf16(v0[0], v0[1]); w.y = cvt_pk_bf16(v0[2], v0[3]); w.z = cvt_pk_bf16(v1[0], v1[1]); w.w = cvt_pk_bf16(v1[2], v1[3]);
                    *(u32x4*)(rowp + bj * HALF) = w; } }
    }
};
struct EpiSwiglu {
    static constexpr bool FUSED = false;
    bf16_t* O; int ldc; const float* rstd;
    __device__ __forceinline__ void prefetch(const Unit& u, int wr, int fr, float (&rf)[2][4]) const {
        const int row0 = u.pm * BM + wr * 64 + fr;
#pragma unroll
        for (int ai = 0; ai < 2; ++ai)
#pragma unroll
            for (int m = 0; m < 4; ++m) { const f32x4 q4 = *(const f32x4*)(rstd + (size_t)(row0 + ai * HALF + m * 16) * 4); rf[ai][m] = 1.0f / sqrtf(((q4[0] + q4[1]) + (q4[2] + q4[3])) * (1.f / DM) + NORM_EPS); }
    }
    __device__ __forceinline__ void operator()(const f32x4 (&acc)[2][2][4][2], const Unit& u, int wr, int wc, int fr, int fq, const float (&rsv)[2][4]) const {
        const int row0 = u.pm * BM + wr * 64 + fr, col0 = u.pn * HALF + wc * 32 + 8 * fq;
#pragma unroll
        for (int ai = 0; ai < 2; ++ai)
#pragma unroll
            for (int m = 0; m < 4; ++m) { bf16_t* rowp = O + (size_t)(row0 + ai * HALF + m * 16) * ldc + col0;
                const float rs = rsv[ai][m];
                float h[8];
#pragma unroll
                for (int n = 0; n < 2; ++n)
#pragma unroll
                    for (int e = 0; e < 4; ++e) { const float a = acc[ai][0][m][n][e] * rs, b = acc[ai][1][m][n][e] * rs; h[n * 4 + e] = a * sigmoidf_fast(a) * b; }
                u32x4 w; w.x = cvt_pk_bf16(h[0], h[1]); w.y = cvt_pk_bf16(h[2], h[3]); w.z = cvt_pk_bf16(h[4], h[5]); w.w = cvt_pk_bf16(h[6], h[7]);
                *(u32x4*)rowp = w; }
    }
};
struct EpiRope {
    static constexpr bool FUSED = false;
    bf16_t* O; int ldc; const float* tab; const float* rstd;
    __device__ __forceinline__ void prefetch(const Unit& u, int wr, int fr, float (&rf)[2][4]) const {
        const int row0 = u.pm * BM + wr * 64 + fr;
#pragma unroll
        for (int ai = 0; ai < 2; ++ai)
#pragma unroll
            for (int m = 0; m < 4; ++m) { const f32x4 q4 = *(const f32x4*)(rstd + (size_t)(row0 + ai * HALF + m * 16) * 4); rf[ai][m] = 1.0f / sqrtf(((q4[0] + q4[1]) + (q4[2] + q4[3])) * (1.f / DM) + NORM_EPS); }
    }
    __device__ __forceinline__ void operator()(const f32x4 (&acc)[2][2][4][2], const Unit& u, int wr, int wc, int fr, int fq, const float (&rsv)[2][4]) const {
        const int row0 = u.pm * BM + wr * 64 + fr, col0 = u.pn * BM + wc * 32 + 8 * fq;
#pragma unroll
        for (int bj = 0; bj < 2; ++bj) {
            const int cw = u.pn * BM + bj * HALF + wc * 32;
            const bool rot = (cw >= 256) && (cw < 1280) && ((cw & 63) == 0);
#pragma unroll
            for (int ai = 0; ai < 2; ++ai)
#pragma unroll
                for (int m = 0; m < 4; ++m) { const int row = row0 + ai * HALF + m * 16;
                    const float rs = rsv[ai][m];
                    f32x4 v0 = acc[ai][bj][m][0] * rs, v1 = acc[ai][bj][m][1] * rs;
                    if (rot) {
                        const f32x4 c0 = *(const f32x4*)(tab + (size_t)row * 16), c1 = *(const f32x4*)(tab + (size_t)row * 16 + 4);
                        const f32x4 s0 = *(const f32x4*)(tab + (size_t)row * 16 + 8), s1 = *(const f32x4*)(tab + (size_t)row * 16 + 12);
                        f32x4 o0, o1;
#pragma unroll
                        for (int e = 0; e < 4; ++e) { o0[e] = __shfl_xor(v0[e], 16); o1[e] = __shfl_xor(v1[e], 16); }
                        const float sg = (fq == 0) ? -1.f : 1.f;
                        if (fq < 2) { v0 = v0 * c0 + (o0 * s0) * sg; v1 = v1 * c1 + (o1 * s1) * sg; }
                    }
                    u32x4 w; w.x = cvt_pk_bf16(v0[0], v0[1]); w.y = cvt_pk_bf16(v0[2], v0[3]); w.z = cvt_pk_bf16(v1[0], v1[1]); w.w = cvt_pk_bf16(v1[2], v1[3]);
                    *(u32x4*)(O + (size_t)row * ldc + col0 + bj * HALF) = w; }
        }
    }
};

struct PanelSsq {
    float* slots;
    unsigned* cnt;
    unsigned target;
    __device__ __forceinline__ void run(float (&part)[2][4], const Unit& u, int wr, int wc, int fr, int fq, LAS float* P, LAS float* S, int tid) const {
#pragma unroll
        for (int ai = 0; ai < 2; ++ai)
#pragma unroll
            for (int m = 0; m < 4; ++m) { float v = part[ai][m]; v += __shfl_xor(v, 16); v += __shfl_xor(v, 32);
                if (fq == 0) P[(ai * HALF + wr * 64 + m * 16 + fr) * 4 + wc] = v; }
        asm volatile("s_waitcnt lgkmcnt(0)" ::: "memory"); __builtin_amdgcn_s_barrier(); asm volatile("" ::: "memory");
        if (tid < 256) {
            const float sv = (P[tid * 4 + 0] + P[tid * 4 + 1]) + (P[tid * 4 + 2] + P[tid * 4 + 3]);
            __hip_atomic_store(slots + ((size_t)(u.pm * BM + tid) * 4 + u.pn), sv, __ATOMIC_RELAXED, __HIP_MEMORY_SCOPE_AGENT);
            asm volatile("s_waitcnt vmcnt(0)" ::: "memory");
            if ((tid & 63) == 0) __hip_atomic_fetch_add(cnt + 64 * u.pm, 1u, __ATOMIC_RELAXED, __HIP_MEMORY_SCOPE_AGENT);
        }
        if (tid < 64) {
            unsigned sp = 0;
            while ((unsigned)__builtin_amdgcn_readfirstlane(__hip_atomic_load(cnt + 64 * u.pm, __ATOMIC_RELAXED, __HIP_MEMORY_SCOPE_AGENT)) < target) {
                __builtin_amdgcn_s_sleep(2); if (++sp > (1u << 22)) break; }
            __builtin_amdgcn_fence(__ATOMIC_ACQUIRE, "agent");
        }
        asm volatile("s_waitcnt vmcnt(0) lgkmcnt(0)" ::: "memory"); __builtin_amdgcn_s_barrier(); asm volatile("" ::: "memory");
        if (tid < 256) {
            const float* sl = slots + (size_t)(u.pm * BM + tid) * 4;
            const float t0 = __hip_atomic_load(sl + 0, __ATOMIC_RELAXED, __HIP_MEMORY_SCOPE_AGENT), t1 = __hip_atomic_load(sl + 1, __ATOMIC_RELAXED, __HIP_MEMORY_SCOPE_AGENT);
            const float t2 = __hip_atomic_load(sl + 2, __ATOMIC_RELAXED, __HIP_MEMORY_SCOPE_AGENT), t3 = __hip_atomic_load(sl + 3, __ATOMIC_RELAXED, __HIP_MEMORY_SCOPE_AGENT);
            S[tid] = (t0 + t1) + (t2 + t3);
        }
        asm volatile("s_waitcnt vmcnt(0) lgkmcnt(0)" ::: "memory"); __builtin_amdgcn_s_barrier(); asm volatile("" ::: "memory");
    }
};
struct EpiNorm {
    static constexpr bool FUSED = true;
    bf16_t* XB; float* Fout; const float* gpost; float scale; float* ssq2; PanelSsq x1;
    __device__ __forceinline__ void prefetch(const Unit&, int, int, float (&)[2][4]) const {}
    __device__ __forceinline__ void fused(f32x4 (&acc)[2][2][4][2], const Unit& u, int wr, int wc, int fr, int fq, LAS unsigned char* xl, int tid) const {
        LAS float* P = (LAS float*)xl; LAS float* S = (LAS float*)(xl + 4096);
        const int col0 = u.pn * BM + wc * 32 + 8 * fq;
        float part[2][4];
#pragma unroll
        for (int ai = 0; ai < 2; ++ai)
#pragma unroll
            for (int m = 0; m < 4; ++m) { float q = 0.f;
#pragma unroll
                for (int bj = 0; bj < 2; ++bj)
#pragma unroll
                    for (int n = 0; n < 2; ++n) { const f32x4 v = acc[ai][bj][m][n]; q += (v[0] * v[0] + v[1] * v[1]) + (v[2] * v[2] + v[3] * v[3]); }
                part[ai][m] = q; }
        u32x4 xv[4][2];
#pragma unroll
        for (int m = 0; m < 4; ++m) { const size_t off = (size_t)(u.pm * BM + wr * 64 + m * 16 + fr) * DM + col0;
#pragma unroll
            for (int bj = 0; bj < 2; ++bj) xv[m][bj] = *(const u32x4*)(XB + off + bj * HALF); }
        x1.run(part, u, wr, wc, fr, fq, P, S, tid);
        f32x4 gp[2][2];
#pragma unroll
        for (int bj = 0; bj < 2; ++bj)
#pragma unroll
            for (int n = 0; n < 2; ++n) gp[bj][n] = *(const f32x4*)(gpost + col0 + bj * HALF + 4 * n);
#pragma unroll
        for (int ai = 0; ai < 2; ++ai)
#pragma unroll
            for (int m = 0; m < 4; ++m) { const int rl = ai * HALF + wr * 64 + m * 16 + fr; const size_t off = (size_t)(u.pm * BM + rl) * DM + col0;
                const float rs = scale / sqrtf(S[rl] * (1.f / DM) + NORM_EPS); float q = 0.f;
#pragma unroll
                for (int bj = 0; bj < 2; ++bj) { const u32x4 w = (ai == 0) ? xv[m][bj] : *(const u32x4*)(XB + off + bj * HALF);
                    const f32x4 x0 = (f32x4){bf_lo(w.x), bf_hi(w.x), bf_lo(w.y), bf_hi(w.y)}, x1v = (f32x4){bf_lo(w.z), bf_hi(w.z), bf_lo(w.w), bf_hi(w.w)};
                    const f32x4 n0 = x0 + acc[ai][bj][m][0] * rs * gp[bj][0], n1 = x1v + acc[ai][bj][m][1] * rs * gp[bj][1];
                    q += ((n0[0] * n0[0] + n0[1] * n0[1]) + (n0[2] * n0[2] + n0[3] * n0[3])) + ((n1[0] * n1[0] + n1[1] * n1[1]) + (n1[2] * n1[2] + n1[3] * n1[3]));
                    if (Fout) { *(f32x4*)(Fout + off + bj * HALF) = n0; *(f32x4*)(Fout + off + bj * HALF + 4) = n1; }
                    else { u32x4 o; o.x = cvt_pk_bf16(n0[0], n0[1]); o.y = cvt_pk_bf16(n0[2], n0[3]); o.z = cvt_pk_bf16(n1[0], n1[1]); o.w = cvt_pk_bf16(n1[2], n1[3]); *(u32x4*)(XB + off + bj * HALF) = o; } }
                part[ai][m] = q; }
        if (Fout) return;
#pragma unroll
        for (int ai = 0; ai < 2; ++ai)
#pragma unroll
            for (int m = 0; m < 4; ++m) { float v = part[ai][m]; v += __shfl_xor(v, 16); v += __shfl_xor(v, 32);
                if (fq == 0) P[(ai * HALF + wr * 64 + m * 16 + fr) * 4 + wc] = v; }
        asm volatile("s_waitcnt lgkmcnt(0)" ::: "memory"); __builtin_amdgcn_s_barrier(); asm volatile("" ::: "memory");
        if (tid < 256) ssq2[(size_t)(u.pm * BM + tid) * 4 + u.pn] = (P[tid * 4 + 0] + P[tid * 4 + 1]) + (P[tid * 4 + 2] + P[tid * 4 + 3]);
        asm volatile("s_waitcnt lgkmcnt(0)" ::: "memory"); __builtin_amdgcn_s_barrier(); asm volatile("" ::: "memory");
    }
};

struct GateOrder {
    StaticOrder base;
    __device__ bool next(int i, Unit& u) const { const int j = i / 3, b = i - 3 * j; if (!base.next(j, u)) return false; u.pn += 4 * b; return true; }
};
struct EpiGate {
    static constexpr bool FUSED = false;
    const bf16_t* PG; bf16_t* MRG; const float* bias; const float* rstd; bf16_t* M0;
    __device__ __forceinline__ void prefetch(const Unit& u, int wr, int fr, float (&rf)[2][4]) const {
        const int row0 = u.pm * BM + wr * 64 + fr;
#pragma unroll
        for (int ai = 0; ai < 2; ++ai)
#pragma unroll
            for (int m = 0; m < 4; ++m) { const f32x4 q4 = *(const f32x4*)(rstd + (size_t)(row0 + ai * HALF + m * 16) * 4); rf[ai][m] = 1.0f / sqrtf(((q4[0] + q4[1]) + (q4[2] + q4[3])) * (1.f / DM) + NORM_EPS); }
    }
    __device__ __forceinline__ void operator()(const f32x4 (&acc)[2][2][4][2], const Unit& u, int wr, int wc, int fr, int fq, const float (&rsv)[2][4]) const {
        const int row0 = u.pm * BM + wr * 64 + fr, col0 = u.pn * BM + wc * 32 + 8 * fq, mcol0 = (u.pn & 3) * BM + wc * 32 + 8 * fq;
        const int br = u.pn >> 2;
        const bool first = (br == 0);
        const bf16_t* __restrict__ pg = PG;
        const bf16_t* __restrict__ msrc = (br == 1) ? MRG : M0;
        bf16_t* __restrict__ mdst = (br == 1) ? M0 : MRG;
#pragma unroll
        for (int bj = 0; bj < 2; ++bj) {
            const f32x4 b0 = *(const f32x4*)(bias + col0 + bj * HALF), b1 = *(const f32x4*)(bias + col0 + bj * HALF + 4);
#pragma unroll
            for (int ai = 0; ai < 2; ++ai)
#pragma unroll
                for (int m = 0; m < 4; ++m) { const size_t row = (size_t)(row0 + ai * HALF + m * 16);
                    const u32x4 pv = *(const u32x4*)(pg + row * 3072 + col0 + bj * HALF);
                    u32x4 mo = (u32x4){0u, 0u, 0u, 0u}; if (!first) mo = *(const u32x4*)(msrc + row * DM + mcol0 + bj * HALF);
                    const float rs = rsv[ai][m];
                    const f32x4 v0 = acc[ai][bj][m][0] * rs + b0, v1 = acc[ai][bj][m][1] * rs + b1;
                    const float g0 = sigmoidf_fast(v0[0]) * bf_lo(pv.x) + bf_lo(mo.x), g1 = sigmoidf_fast(v0[1]) * bf_hi(pv.x) + bf_hi(mo.x);
                    const float g2 = sigmoidf_fast(v0[2]) * bf_lo(pv.y) + bf_lo(mo.y), g3 = sigmoidf_fast(v0[3]) * bf_hi(pv.y) + bf_hi(mo.y);
                    const float g4 = sigmoidf_fast(v1[0]) * bf_lo(pv.z) + bf_lo(mo.z), g5 = sigmoidf_fast(v1[1]) * bf_hi(pv.z) + bf_hi(mo.z);
                    const float g6 = sigmoidf_fast(v1[2]) * bf_lo(pv.w) + bf_lo(mo.w), g7 = sigmoidf_fast(v1[3]) * bf_hi(pv.w) + bf_hi(mo.w);
                    u32x4 w; w.x = cvt_pk_bf16(g0, g1); w.y = cvt_pk_bf16(g2, g3); w.z = cvt_pk_bf16(g4, g5); w.w = cvt_pk_bf16(g6, g7);
                    *(u32x4*)(mdst + row * DM + mcol0 + bj * HALF) = w; }
        }
    }
};

template <class Epi, bool ALIGN_EPI, class Sched>
__device__ __forceinline__ void gemm_phase(LAS unsigned char* lds, const Gemm g, const Sched& S, const Epi& E) {
    int tid = threadIdx.x; asm volatile("" : "+v"(tid));
    const int wid = __builtin_amdgcn_readfirstlane(tid >> 6), lane = tid & 63, wr = wid >> 2, wc = wid & 3, fr = lane & 15, fq = lane >> 4;
    const int nt = g.K / BK;
    unsigned voffA[2], voffB[2];
#pragma unroll
    for (int i = 0; i < 2; ++i) { int R, C; stage_rc(tid * 16 + i * 8192, R, C); const int Rb = (R & ~31) + perm32(R & 31);
        voffA[i] = (unsigned)(R * g.lda + C) * 2u; voffB[i] = (unsigned)(Rb * g.ldb + C) * 2u; }
    const size_t kstep = (size_t)(BK * 2);
    const size_t hstepA = (size_t)HALF * g.lda * 2, hstepB = (size_t)HALF * g.ldb * 2;
    const size_t tstepA = 2 * hstepA, tstepB = 2 * hstepB;
    const unsigned ldsw = (unsigned)wid * 1024u;
    const int aoff = lds_byte(wr * 64 + fr, fq * 8), boff = lds_byte(wc * 32 + fr, fq * 8);
#define PG8_SA(b, h) (((b) * 2 + (h)) * HTB)
#define PG8_SB(b, h) ((4 + (b) * 2 + (h)) * HTB)
#define PG8_STAGE(bufoff, gbase, voff) do { _Pragma("unroll") for (int _i = 0; _i < 2; ++_i) \
        __builtin_amdgcn_global_load_lds((const unsigned*)((const char*)(gbase) + (voff)[_i]), (LAS unsigned*)(lds + (bufoff) + ldsw + _i * 8192), 16, 0, 0); } while (0)
#define PG8_LDA(dst, b, h) do { _Pragma("unroll") for (int m = 0; m < 4; ++m) _Pragma("unroll") for (int k = 0; k < 2; ++k) dst[m][k] = *(const LAS bf16x8*)(lds + PG8_SA(b, h) + aoff + m * 2048 + k * 1024); } while (0)
#define PG8_LDB(dst, b, h) do { _Pragma("unroll") for (int n = 0; n < 2; ++n) _Pragma("unroll") for (int k = 0; k < 2; ++k) dst[n][k] = *(const LAS bf16x8*)(lds + PG8_SB(b, h) + boff + n * 2048 + k * 1024); } while (0)
#define PG8_MMA(ai, bj, At, Bt) do { __builtin_amdgcn_s_setprio(1); _Pragma("unroll") for (int m = 0; m < 4; ++m) _Pragma("unroll") for (int n = 0; n < 2; ++n) _Pragma("unroll") for (int k = 0; k < 2; ++k) \
        acc[ai][bj][m][n] = __builtin_amdgcn_mfma_f32_16x16x32_bf16(Bt[n][k], At[m][k], acc[ai][bj][m][n], 0, 0, 0); __builtin_amdgcn_s_setprio(0); } while (0)
#define PG8_WAIT_V(n) asm volatile("s_waitcnt vmcnt(" #n ")" ::: "memory")
#define PG8_WAIT_L(n) asm volatile("s_waitcnt lgkmcnt(" #n ")" ::: "memory")
#define PG8_BAR __builtin_amdgcn_s_barrier()
#define PG8_SCHED __builtin_amdgcn_sched_barrier(0)
    Unit cur, nxt; int ui = 0;
    if (!S.next(0, cur)) return;
    float rowf[2][4] = {}; E.prefetch(cur, wr, fr, rowf);
    f32x4 acc[2][2][4][2];
#pragma unroll
    for (int a = 0; a < 2; ++a)
#pragma unroll
        for (int b = 0; b < 2; ++b)
#pragma unroll
            for (int m = 0; m < 4; ++m)
#pragma unroll
                for (int n = 0; n < 2; ++n) acc[a][b][m][n] = (f32x4){0.f, 0.f, 0.f, 0.f};
    bf16x8 At[4][2], B0[2][2], B1[2][2];
    const char* cA = (const char*)g.A + (size_t)cur.pm * tstepA; const char* cB = (const char*)g.Bt + (size_t)cur.pn * tstepB;
    PG8_STAGE(PG8_SB(0, 0), cB, voffB); PG8_STAGE(PG8_SB(0, 1), cB + hstepB, voffB); PG8_STAGE(PG8_SA(0, 0), cA, voffA); PG8_STAGE(PG8_SA(0, 1), cA + hstepA, voffA);
    if (wr == 1) PG8_BAR;
    PG8_WAIT_V(2); PG8_BAR;
    PG8_STAGE(PG8_SB(1, 0), cB + kstep, voffB); PG8_STAGE(PG8_SA(1, 0), cA + kstep, voffA); PG8_STAGE(PG8_SB(1, 1), cB + hstepB + kstep, voffB);
    PG8_WAIT_V(6); PG8_BAR;
    for (;;) {
        const bool has_next = S.next(ui + 1, nxt);
        const char* nA = has_next ? (const char*)g.A + (size_t)nxt.pm * tstepA : cA; const char* nB = has_next ? (const char*)g.Bt + (size_t)nxt.pn * tstepB : cB;
        for (int t = 0; t < nt; t += 2) {
            const bool last = (t == nt - 2);
            const char* a1 = cA + (size_t)(t + 1) * kstep;
            const char* a2 = last ? nA : cA + (size_t)(t + 2) * kstep; const char* b2 = last ? nB : cB + (size_t)(t + 2) * kstep;
            const char* a3 = a2 + kstep; const char* b3 = b2 + kstep;
            PG8_LDB(B0, 0, 0); PG8_LDB(B1, 0, 1); PG8_SCHED; PG8_LDA(At, 0, 0); PG8_STAGE(PG8_SA(1, 1), a1 + hstepA, voffA);
            PG8_WAIT_V(8); PG8_WAIT_L(0); PG8_BAR; PG8_MMA(0, 0, At, B0); PG8_MMA(0, 1, At, B1); PG8_BAR; PG8_SCHED;
            PG8_LDA(At, 0, 1); PG8_STAGE(PG8_SB(0, 0), b2, voffB); PG8_STAGE(PG8_SB(0, 1), b2 + hstepB, voffB); PG8_STAGE(PG8_SA(0, 0), a2, voffA);
            PG8_WAIT_V(8); PG8_WAIT_L(0); PG8_BAR; PG8_MMA(1, 0, At, B0); PG8_MMA(1, 1, At, B1); PG8_BAR; PG8_SCHED;
            PG8_LDB(B0, 1, 0); PG8_LDB(B1, 1, 1); PG8_SCHED; PG8_LDA(At, 1, 0); PG8_STAGE(PG8_SA(0, 1), a2 + hstepA, voffA);
            PG8_WAIT_V(8); PG8_WAIT_L(0); PG8_BAR; PG8_MMA(0, 0, At, B0); PG8_MMA(0, 1, At, B1); PG8_BAR; PG8_SCHED;
            PG8_LDA(At, 1, 1); PG8_STAGE(PG8_SB(1, 0), b3, voffB); PG8_STAGE(PG8_SB(1, 1), b3 + hstepB, voffB); PG8_STAGE(PG8_SA(1, 0), a3, voffA);
            PG8_WAIT_V(8); PG8_WAIT_L(0); PG8_BAR; PG8_MMA(1, 0, At, B0); PG8_MMA(1, 1, At, B1); PG8_BAR; PG8_SCHED;
        }
        if constexpr (ALIGN_EPI) { if (wr == 0) PG8_BAR; }
        if constexpr (Epi::FUSED) E.fused(acc, cur, wr, wc, fr, fq, lds + STAGE_BYTES + 256, tid); else E(acc, cur, wr, wc, fr, fq, rowf);
        if (!has_next) break;
#pragma unroll
        for (int a = 0; a < 2; ++a)
#pragma unroll
            for (int b = 0; b < 2; ++b)
#pragma unroll
                for (int m = 0; m < 4; ++m)
#pragma unroll
                    for (int n = 0; n < 2; ++n) acc[a][b][m][n] = (f32x4){0.f, 0.f, 0.f, 0.f};
        cur = nxt; cA = nA; cB = nB; ++ui; E.prefetch(cur, wr, fr, rowf);
        if constexpr (ALIGN_EPI) { if (wr == 1) PG8_BAR; }
    }
    PG8_WAIT_V(0);
    if constexpr (!ALIGN_EPI) { if (wr == 0) PG8_BAR; }
    PG8_BAR;
#undef PG8_SA
#undef PG8_SB
#undef PG8_STAGE
#undef PG8_LDA
#undef PG8_LDB
#undef PG8_MMA
#undef PG8_WAIT_V
#undef PG8_WAIT_L
#undef PG8_BAR
#undef PG8_SCHED
}
}

namespace att {
#define SBAR() __builtin_amdgcn_sched_barrier(0)
#define SGB(mask, n) __builtin_amdgcn_sched_group_barrier((mask), (n), 0)
constexpr float SCALE = 0.125f;
constexpr float THR = 8.f;
constexpr int SHM_K = 64 * 64 * 2;
#define KSWZ(row, colB) ((row) * 128 + ((colB) ^ ((((row) >> 1) & 7) << 4)))
typedef __bf16 bf16x2_t __attribute__((ext_vector_type(2)));
typedef short v4i16_t __attribute__((ext_vector_type(4)));
typedef LAS const char* lds_cptr;
__device__ __forceinline__ int crow(int r, int hi) { return (r & 3) + 8 * (r >> 2) + 4 * hi; }
__device__ __forceinline__ unsigned cvtpk_s(float lo, float hi) { f32x2 v = {lo, hi}; bf16x2_t b = __builtin_convertvector(v, bf16x2_t); return __builtin_bit_cast(unsigned, b); }
__device__ __forceinline__ s16x4 vtr(lds_cptr p) { return __builtin_bit_cast(s16x4, __builtin_amdgcn_ds_read_tr16_b64_v4i16((LAS v4i16_t*)p)); }

__device__ __forceinline__ void psm_max(const f32x16& p0, const f32x16& p1, float& m_reg, float& alpha, float& mnC) {
    constexpr float C = SCALE * 1.4426950408889634f;
    float pa = fmaxf(fmaxf(p0[0], p0[1]), p1[0]), pb = fmaxf(fmaxf(p0[2], p0[3]), p1[1]); pa = fmaxf(fmaxf(pa, p1[2]), p1[3]);
#pragma unroll
    for (int r = 4; r < 16; r += 4) { pa = fmaxf(fmaxf(pa, p0[r]), p0[r + 1]); pb = fmaxf(fmaxf(pb, p0[r + 2]), p0[r + 3]); pa = fmaxf(fmaxf(pa, p1[r]), p1[r + 1]); pb = fmaxf(fmaxf(pb, p1[r + 2]), p1[r + 3]); }
    float pmax = fmaxf(pa, pb);
    { auto rr = __builtin_amdgcn_permlane32_swap(__float_as_uint(pmax), __float_as_uint(pmax), false, false);
      pmax = fmaxf(__uint_as_float(rr[0]), __uint_as_float(rr[1])); }
    const float mn = (pmax - m_reg > THR / SCALE) ? pmax : m_reg;
    alpha = __builtin_amdgcn_exp2f((m_reg - mn) * C); m_reg = mn;
    mnC = -mn * C;
}
__device__ __forceinline__ void psm_scale(f32x16& p0, f32x16& p1, float mnC) {
    constexpr float C = SCALE * 1.4426950408889634f;
#pragma unroll
    for (int r = 0; r < 16; ++r) p0[r] = fmaf(p0[r], C, mnC);
#pragma unroll
    for (int r = 0; r < 16; ++r) p1[r] = fmaf(p1[r], C, mnC);
}
template <int LO> __device__ __forceinline__ void psm_exp(f32x16& p0) {
#pragma unroll
    for (int r = LO; r < LO + 8; ++r) p0[r] = __builtin_amdgcn_exp2f(p0[r]);
}
__device__ __forceinline__ void partialSM(f32x16& p0, f32x16& p1, float& m_reg, float& alpha) {
    float mnC; psm_max(p0, p1, m_reg, alpha, mnC); psm_scale(p0, p1, mnC); psm_exp<0>(p0); psm_exp<8>(p0);
}
__device__ __forceinline__ void finishSM(f32x16& p0, f32x16& p1, float alpha, float& l_reg, bf16x8& pa0, bf16x8& pa1, bf16x8& pa2, bf16x8& pa3) {
#pragma unroll
    for (int r = 0; r < 16; ++r) p1[r] = __builtin_amdgcn_exp2f(p1[r]);
    float ps0 = 0.f, ps1 = 0.f;
#pragma unroll
    for (int r = 0; r < 16; ++r) { ps0 += p0[r]; ps1 += p1[r]; }
    float ps = ps0 + ps1;
    { auto rr = __builtin_amdgcn_permlane32_swap(__float_as_uint(ps), __float_as_uint(ps), false, false);
      ps = __uint_as_float(rr[0]) + __uint_as_float(rr[1]); }
    l_reg = l_reg * alpha + ps;
#define PK4(P, BASE, OUT) do { unsigned a0 = cvtpk_s(P[BASE + 0], P[BASE + 1]), a1 = cvtpk_s(P[BASE + 2], P[BASE + 3]);   \
    unsigned b0 = cvtpk_s(P[BASE + 4], P[BASE + 5]), b1 = cvtpk_s(P[BASE + 6], P[BASE + 7]);                              \
    auto r0 = __builtin_amdgcn_permlane32_swap(a0, b0, false, false); auto r1 = __builtin_amdgcn_permlane32_swap(a1, b1, false, false); \
    u32x4 w = {r0[0], r1[0], r0[1], r1[1]}; OUT = __builtin_bit_cast(bf16x8, w); } while (0)
    PK4(p0, 0, pa0); PK4(p0, 8, pa1); PK4(p1, 0, pa2); PK4(p1, 8, pa3);
#undef PK4
}
__device__ __forceinline__ void qkt(f32x16& p0, f32x16& p1, lds_cptr Ks, const bf16x8* qr, int r32, int hi) {
    p0 = f32x16{}; p1 = f32x16{};
    bf16x8 b0[4], b1[4];
#pragma unroll
    for (int d0 = 0; d0 < 4; ++d0) { const int cb = (d0 * 16 + hi * 8) * 2;
        b0[d0] = *reinterpret_cast<const LAS bf16x8*>(Ks + KSWZ(r32, cb));
        b1[d0] = *reinterpret_cast<const LAS bf16x8*>(Ks + KSWZ(32 + r32, cb)); }
#pragma unroll
    for (int d0 = 0; d0 < 4; ++d0) {
        p0 = __builtin_amdgcn_mfma_f32_32x32x16_bf16(b0[d0], qr[d0], p0, 0, 0, 0);
        p1 = __builtin_amdgcn_mfma_f32_32x32x16_bf16(b1[d0], qr[d0], p1, 0, 0, 0); }
}
template <int DV> __device__ __forceinline__ int v_st(int k, int c) { const int kk = (k & ~0xC) | ((k & 4) << 1) | ((k & 8) >> 1); return ((kk >> 3) * (DV / 32) + (c >> 5)) * 512 + ((kk & 7) * 32 + (c & 31)) * 2; }
__device__ __forceinline__ int v_rd_base(int lane) { return ((lane & 3) << 3) | (((lane >> 2) & 3) << 6) | (((lane >> 4) & 1) << 5) | (((lane >> 5) & 1) << 8); }
template <int DV> struct VFrag { s16x4 l[DV / 32], h[DV / 32]; };
template <int DV, int KS_IDX> __device__ __forceinline__ void v_rd(VFrag<DV>& f, lds_cptr vb) {
    constexpr int KS = DV * 32, HF = DV * 16;
#pragma unroll
    for (int d = 0; d < DV / 32; ++d) { f.l[d] = vtr(vb + d * 512 + KS_IDX * KS); f.h[d] = vtr(vb + d * 512 + KS_IDX * KS + HF); }
}
template <int DV> __device__ __forceinline__ void v_mma(f32x16* o, const VFrag<DV>& f, bf16x8 pa) {
#pragma unroll
    for (int d = 0; d < DV / 32; ++d) o[d] = __builtin_amdgcn_mfma_f32_32x32x16_bf16(pa, (bf16x8){f.l[d][0], f.l[d][1], f.l[d][2], f.l[d][3], f.h[d][0], f.h[d][1], f.h[d][2], f.h[d][3]}, o[d], 0, 0, 0);
}
template <int DV> __device__ __forceinline__ void pv_all(f32x16* o, lds_cptr vb, bf16x8 pa0, bf16x8 pa1, bf16x8 pa2, bf16x8 pa3) {
    VFrag<DV> A, B;
    v_rd<DV, 0>(A, vb); v_rd<DV, 1>(B, vb); v_mma<DV>(o, A, pa0);
    v_rd<DV, 2>(A, vb); v_mma<DV>(o, B, pa1);
    v_rd<DV, 3>(B, vb); v_mma<DV>(o, A, pa2);
    v_mma<DV>(o, B, pa3);
}
template <int DV> __device__ __forceinline__ void pv_psm(f32x16* o, lds_cptr vb, bf16x8 pa0, bf16x8 pa1, bf16x8 pa2, bf16x8 pa3, f32x16& p0, f32x16& p1, float& m_reg, float& alpha) {
    constexpr int ND = DV / 32, NV = (DV == 128) ? 8 : 16;
    VFrag<DV> A, B; float mnC;
    v_rd<DV, 0>(A, vb); SBAR();
    v_rd<DV, 1>(B, vb); v_mma<DV>(o, A, pa0); psm_max(p0, p1, m_reg, alpha, mnC);
    SGB(0x100, 2 * ND);
#pragma unroll
    for (int i = 0; i < ND; ++i) { SGB(0x008, 1); SGB(0x002, NV); }
    SBAR();
    v_rd<DV, 2>(A, vb); v_mma<DV>(o, B, pa1); psm_scale(p0, p1, mnC);
    SGB(0x100, 2 * ND);
#pragma unroll
    for (int i = 0; i < ND; ++i) { SGB(0x008, 1); SGB(0x002, NV); }
    SBAR();
    v_rd<DV, 3>(B, vb); v_mma<DV>(o, A, pa2); psm_exp<0>(p0);
    SGB(0x100, 2 * ND);
#pragma unroll
    for (int i = 0; i < ND; ++i) { SGB(0x008, 1); SGB(0x400, 8 / ND); }
    SBAR();
    v_mma<DV>(o, B, pa3); psm_exp<8>(p0);
#pragma unroll
    for (int i = 0; i < ND; ++i) { SGB(0x008, 1); SGB(0x400, 8 / ND); }
    asm volatile("" : "+v"(p0), "+v"(p1));
    SBAR();
}

template <int DV, int ldq, int ldk, int ldv>
__device__ __forceinline__ void attn_pass(const bf16_t* __restrict__ Qw, const bf16_t* __restrict__ Kh, const bf16_t* __restrict__ Vh,
                                          int NT, char* lds, f32x16 (&o)[DV / 32], float& l_out) {
    constexpr int ND = DV / 32, SHM_V = 64 * DV * 2, NVP = DV / 64;
    int tid = threadIdx.x; asm volatile("" : "+v"(tid));
    const int wid = __builtin_amdgcn_readfirstlane(tid >> 6), lane = tid & 63, r32 = lane & 31, hi = lane >> 5;
    const lds_cptr lds3 = (lds_cptr)lds;
    const lds_cptr V3 = lds3, K3 = lds3 + 4 * SHM_V;
    LAS float* al_l = (LAS float*)(lds3 + 4 * SHM_V + 4 * SHM_K) + wid * 64 + 32;
    LAS unsigned char* Vw = (LAS unsigned char*)lds3; LAS unsigned char* Kw = (LAS unsigned char*)lds3 + 4 * SHM_V;
    float m_reg = -1e30f, l_reg = 0; bf16x8 qr[4];
#pragma unroll
    for (int d = 0; d < ND; ++d) o[d] = f32x16{};
    const bf16_t* Ql = Qw + r32 * ldq + hi * 8;
#pragma unroll
    for (int d0 = 0; d0 < 4; ++d0) qr[d0] = *reinterpret_cast<const bf16x8*>(Ql + d0 * 16);
    const int krow = 8 * wid + (lane >> 3), kch = (lane & 7) ^ ((krow >> 1) & 7);
    const bf16_t* ksrc = Kh + krow * ldk + kch * 8;
    const bf16_t* vsrc[NVP];
#pragma unroll
    for (int i = 0; i < NVP; ++i) { const int p = (NVP * wid + i) * 64 + lane, st = p >> 5, kk = (st / (DV / 32)) * 8 + ((p >> 2) & 7);
        const int k = (kk & ~0xC) | ((kk & 4) << 1) | ((kk & 8) >> 1), c = (st % (DV / 32)) * 32 + (p & 3) * 8; vsrc[i] = Vh + k * ldv + c; }
    const lds_cptr vb0 = V3 + v_rd_base(lane);
#define DMA(t, slot) do { __builtin_amdgcn_global_load_lds((const unsigned*)(ksrc + (size_t)(t) * 64 * ldk), (LAS unsigned*)(Kw + (slot) * SHM_K + wid * 1024), 16, 0, 0); \
    _Pragma("unroll") for (int _i = 0; _i < NVP; ++_i) __builtin_amdgcn_global_load_lds((const unsigned*)(vsrc[_i] + (size_t)(t) * 64 * ldv), (LAS unsigned*)(Vw + (slot) * SHM_V + (NVP * wid + _i) * 1024), 16, 0, 0); } while (0)
#define RESC(a) do { if (__any((a) < 1.f)) { if (hi == 0) al_l[r32] = (a); \
    _Pragma("unroll") for (int d = 0; d < ND; ++d) _Pragma("unroll") for (int r = 0; r < 16; ++r) o[d][r] *= al_l[crow(r, hi)]; } } while (0)
#define HINT_R1() do { SGB(0x100, 8); _Pragma("unroll") for (int _i = 0; _i < 8; ++_i) { SGB(0x008, 1); SGB(0x400, 2); SGB(0x002, 10); } } while (0)
#define DRAIN_BAR() do { asm volatile("s_waitcnt vmcnt(0) lgkmcnt(0)\n\ts_barrier" ::: "memory"); } while (0)
#define COUNT_BAR() do { if constexpr (DV == 128) asm volatile("s_waitcnt vmcnt(3) lgkmcnt(0)\n\ts_barrier" ::: "memory"); else asm volatile("s_waitcnt vmcnt(2) lgkmcnt(0)\n\ts_barrier" ::: "memory"); } while (0)
    f32x16 pA0, pA1, pB0, pB1; float alA, alB; bf16x8 pa0, pa1, pa2, pa3;
    DMA(0, 0); DMA(1, 1); DMA(2, 2); DRAIN_BAR();
    qkt(pA0, pA1, K3, qr, r32, hi); partialSM(pA0, pA1, m_reg, alA);
#define BODY(Pc0, Pc1, alc, Pn0, Pn1, aln, j) do { \
        const bool more_ = ((j) + 3 < NT); \
        if (more_) DMA((j) + 3, ((j) + 3) & 3); \
        SBAR(); qkt(Pn0, Pn1, K3 + (((j) + 1) & 3) * SHM_K, qr, r32, hi); \
        finishSM(Pc0, Pc1, alc, l_reg, pa0, pa1, pa2, pa3); HINT_R1(); SBAR(); \
        pv_psm<DV>(o, vb0 + ((j) & 3) * SHM_V, pa0, pa1, pa2, pa3, Pn0, Pn1, m_reg, aln); \
        RESC(aln); if (more_) COUNT_BAR(); else DRAIN_BAR(); } while (0)
    for (int j = 0; j + 2 < NT; j += 2) {
        BODY(pA0, pA1, alA, pB0, pB1, alB, j);
        BODY(pB0, pB1, alB, pA0, pA1, alA, j + 1);
    }
    BODY(pA0, pA1, alA, pB0, pB1, alB, NT - 2);
    finishSM(pB0, pB1, alB, l_reg, pa0, pa1, pa2, pa3); SBAR();
    pv_all<DV>(o, vb0 + ((NT - 1) & 3) * SHM_V, pa0, pa1, pa2, pa3);
    l_out = l_reg;
    __syncthreads();
#undef DMA
#undef RESC
#undef HINT_R1
#undef DRAIN_BAR
#undef COUNT_BAR
#undef BODY
}
template <int DV> __device__ __forceinline__ void row_rcp(char* lds, float l_reg, float (&rli)[16]) {
    int tid = threadIdx.x; asm volatile("" : "+v"(tid));
    const int wid = tid >> 6, lane = tid & 63, r32 = lane & 31, hi = lane >> 5;
    LAS float* li_l = (LAS float*)((lds_cptr)lds + 4 * (64 * DV * 2) + 4 * SHM_K) + wid * 64;
    if (hi == 0) li_l[r32] = l_reg;
#pragma unroll
    for (int r = 0; r < 16; ++r) rli[r] = __builtin_amdgcn_rcpf(li_l[crow(r, hi)]);
}
}

struct Args { const void* in[29]; float* out; unsigned char* ws; };

struct Ctx {
    int wave, vcu, G, gw, NGW;
    unsigned char* ws;
};
__device__ __forceinline__ int opaque_tid() { int t = threadIdx.x; asm volatile("" : "+v"(t)); return t; }

__device__ __forceinline__ void transpose_item(const float* W, int N, bf16_t* WT, int ldt, int coff, int mode, LAS float* scr, int item, int lane, const float* gk = nullptr) {
    const int nblk = N / 32, kb = item / nblk, nb = item % nblk, k0 = 64 * kb, n0 = 32 * nb;
    float wv[32];
#pragma unroll
    for (int i = 0; i < 32; ++i) { const int kk = 2 * i + (lane >> 5); wv[i] = __builtin_nontemporal_load(W + (size_t)(k0 + kk) * N + n0 + (lane & 31)); }
    if (gk) {
#pragma unroll
        for (int i = 0; i < 32; ++i) wv[i] *= gk[k0 + 2 * i + (lane >> 5)]; }
#pragma unroll
    for (int i = 0; i < 32; ++i) { const int kk = 2 * i + (lane >> 5); scr[kk * 33 + (lane & 31)] = wv[i]; }
    asm volatile("s_waitcnt lgkmcnt(0)" ::: "memory");
    int d0 = n0;
    if (mode == 1) d0 = (n0 < FF) ? ((n0 >> 7) * 256 + (n0 & 127)) : (((n0 - FF) >> 7) * 256 + 128 + ((n0 - FF) & 127));
    const int c = lane & 7;
#pragma unroll
    for (int j = 0; j < 4; ++j) { const int n = (lane >> 3) + 8 * j; const LAS float* s = scr + (8 * c) * 33 + n;
        u32x4 o; o.x = cvt_pk_bf16(s[0 * 33], s[1 * 33]); o.y = cvt_pk_bf16(s[2 * 33], s[3 * 33]); o.z = cvt_pk_bf16(s[4 * 33], s[5 * 33]); o.w = cvt_pk_bf16(s[6 * 33], s[7 * 33]);
        *(u32x4*)(WT + (size_t)(d0 + n) * ldt + coff + k0 + 8 * c) = o; }
    asm volatile("s_waitcnt lgkmcnt(0)" ::: "memory");
}

__device__ __forceinline__ void convert_layer(const Ctx& C, const Args& A, LAS unsigned char* lds, int l) {
    const int lane = opaque_tid() & 63;
    LAS float* scr = (LAS float*)(lds + C.wave * 16384);
    unsigned char* wb = C.ws + WS_W;
    const float* up1 = (const float*)A.in[4] + (size_t)l * DM * NUP;  const float* dn1 = (const float*)A.in[5] + (size_t)l * FF * DM;
    const float* win = (const float*)A.in[8] + (size_t)l * DM * INW;  const float* wg = (const float*)A.in[18] + (size_t)l * DM * 3072;
    const float* brp = (const float*)A.in[20] + (size_t)l * 256 * DM; const float* brd = (const float*)A.in[21] + (size_t)l * 512 * DM;
    const float* brc = (const float*)A.in[22] + (size_t)l * 256 * DM; const float* wo = (const float*)A.in[23] + (size_t)l * DM * DM;
    const float* up2 = (const float*)A.in[26] + (size_t)l * DM * NUP; const float* dn2 = (const float*)A.in[27] + (size_t)l * FF * DM;
    const float* g_f1 = (const float*)A.in[3] + (size_t)l * DM; const float* g_mx = (const float*)A.in[7] + (size_t)l * DM; const float* g_f2 = (const float*)A.in[25] + (size_t)l * DM;
    const float* wkv = (const float*)A.in[17] + (size_t)l * DM * 512; const float* pw = (const float*)A.in[9] + (size_t)l * 4 * 64 * 64;
    constexpr int I_UP = (DM / 64) * (NUP / 32), I_DN = (FF / 64) * (DM / 32), I_IN = (DM / 64) * (INW / 32), I_G = (DM / 64) * (3072 / 32),
                  I_BP = (256 / 64) * (DM / 32), I_BD = (512 / 64) * (DM / 32), I_O = (DM / 64) * (DM / 32), I_KV = (DM / 64) * (512 / 32), I_PW = 2;
    constexpr int NITEMS = 2 * I_UP + 2 * I_DN + I_IN + I_G + 2 * I_BP + I_BD + I_O + I_KV + 4 * I_PW;
    for (int it = C.gw; it < NITEMS; it += C.NGW) {
        int r = it;
#define TR(Wp, Kk, Nn, WTo, ldt, coff, mode, NI) if (r < (NI)) { transpose_item((Wp), (Nn), (bf16_t*)(wb + (WTo)), (ldt), (coff), (mode), scr, r, lane); continue; } r -= (NI);
#define TRG(Wp, Kk, Nn, WTo, ldt, coff, mode, NI, G) if (r < (NI)) { transpose_item((Wp), (Nn), (bf16_t*)(wb + (WTo)), (ldt), (coff), (mode), scr, r, lane, (G)); continue; } r -= (NI);
        TRG(up1, DM, NUP, W_UP1, DM, 0, 1, I_UP, g_f1)
        TRG(up2, DM, NUP, W_UP2, DM, 0, 1, I_UP, g_f2)
        TR(dn1, FF, DM, W_DN1, FF, 0, 0, I_DN)
        TR(dn2, FF, DM, W_DN2, FF, 0, 0, I_DN)
        TRG(win, DM, INW, W_IN, DM, 0, 0, I_IN, g_mx)
        TRG(wg, DM, 3072, W_GATE, DM, 0, 0, I_G, g_mx)
        TR(brp, 256, DM, W_BRP, 256, 0, 0, I_BP)
        TR(brd, 512, DM, W_BRD, 512, 0, 0, I_BD)
        TR(brc, 256, DM, W_BRC, 256, 0, 0, I_BP)
        TR(wo, DM, DM, W_OUT3, DM, 0, 0, I_O)
        TR(wkv, DM, 512, W_KV, DM, 0, 0, I_KV)
        TR(pw, 64, 64, W_POOL, 64, 0, 0, I_PW)
        TR(pw + 4096, 64, 64, W_POOL + 8192, 64, 0, 0, I_PW)
        TR(pw + 8192, 64, 64, W_POOL + 16384, 64, 0, 0, I_PW)
        TR(pw + 12288, 64, 64, W_POOL + 24576, 64, 0, 0, I_PW)
#undef TR
#undef TRG
    }
    const float* mem = (const float*)A.in[1]; const float* mg = (const float*)A.in[16] + (size_t)l * DM; bf16_t* memn = (bf16_t*)(C.ws + WS_MEMN);
    for (int row = C.gw; row < NBATCH * NMEM; row += C.NGW) {
        const f32x4* xr = (const f32x4*)(mem + (size_t)row * DM) + lane; f32x4 v[4]; float ss = 0.f;
#pragma unroll
        for (int j = 0; j < 4; ++j) { v[j] = xr[64 * j]; ss += (v[j].x * v[j].x + v[j].y * v[j].y) + (v[j].z * v[j].z + v[j].w * v[j].w); }
        const float rs = 1.0f / sqrtf(wave_sum(ss) * (1.f / DM) + NORM_EPS);
#pragma unroll
        for (int j = 0; j < 4; ++j) { const f32x4 gg = *((const f32x4*)mg + lane + 64 * j); const f32x4 t = v[j] * rs * gg;
            u32x2 w; w.x = cvt_pk_bf16(t.x, t.y); w.y = cvt_pk_bf16(t.z, t.w); *((u32x2*)(memn + (size_t)row * DM) + lane + 64 * j) = w; }
    }
}

__device__ __forceinline__ void norm_phase(const Ctx& C, const float* Xf, bf16_t* XB, const bf16_t* T1, const float* gpost, float scale, float* rstd, float* Fout, bf16_t* XBo = nullptr) {
    if (XBo == nullptr) XBo = XB;
    const int lane = opaque_tid() & 63;
    for (int row0 = C.gw; row0 < NTOK; row0 += 2 * C.NGW) {
        f32x4 v[2][4]; u32x2 tw[2][4];
#pragma unroll
        for (int q = 0; q < 2; ++q) { const int row = row0 + q * C.NGW;
            if (Xf) {
#pragma unroll
                for (int j = 0; j < 4; ++j) v[q][j] = __builtin_nontemporal_load((const f32x4*)(Xf + (size_t)row * DM) + lane + 64 * j);
            } else {
#pragma unroll
                for (int j = 0; j < 4; ++j) { const u32x2 w = *((const u32x2*)(XB + (size_t)row * DM) + lane + 64 * j); v[q][j] = (f32x4){bf_lo(w.x), bf_hi(w.x), bf_lo(w.y), bf_hi(w.y)}; }
            }
            if (T1) {
#pragma unroll
                for (int j = 0; j < 4; ++j) tw[q][j] = __builtin_nontemporal_load((const u32x2*)(T1 + (size_t)row * DM) + lane + 64 * j);
            } }
#pragma unroll
        for (int q = 0; q < 2; ++q) { const int row = row0 + q * C.NGW;
            if (T1) {
                f32x4 t[4]; float ss = 0.f;
#pragma unroll
                for (int j = 0; j < 4; ++j) { const u32x2 w = tw[q][j];
                    t[j] = (f32x4){bf_lo(w.x), bf_hi(w.x), bf_lo(w.y), bf_hi(w.y)}; ss += (t[j].x * t[j].x + t[j].y * t[j].y) + (t[j].z * t[j].z + t[j].w * t[j].w); }
                const float rs = scale / sqrtf(wave_sum(ss) * (1.f / DM) + NORM_EPS);
#pragma unroll
                for (int j = 0; j < 4; ++j) { const f32x4 gg = *((const f32x4*)gpost + lane + 64 * j); v[q][j] = v[q][j] + t[j] * rs * gg; }
            }
            if (Fout) {
#pragma unroll
                for (int j = 0; j < 4; ++j) __builtin_nontemporal_store(v[q][j], (f32x4*)(Fout + (size_t)row * DM) + lane + 64 * j);
            } else {
                float ss = 0.f;
#pragma unroll
                for (int j = 0; j < 4; ++j) { ss += (v[q][j].x * v[q][j].x + v[q][j].y * v[q][j].y) + (v[q][j].z * v[q][j].z + v[q][j].w * v[q][j].w);
                    u32x2 w; w.x = cvt_pk_bf16(v[q][j].x, v[q][j].y); w.y = cvt_pk_bf16(v[q][j].z, v[q][j].w); *((u32x2*)(XBo + (size_t)row * DM) + lane + 64 * j) = w; }
                const float st = wave_sum(ss);
                if (lane == 0) *(f32x4*)(rstd + (size_t)row * 4) = (f32x4){st, 0.f, 0.f, 0.f};
            }
        }
    }
}

__device__ __forceinline__ void rope_table(const Ctx& C, const Args& A) {
    const int* pos = (const int*)A.in[2]; float* tab = (float*)(C.ws + WS_ROPE);
    const int tid = opaque_tid();
    for (int idx = blockIdx.x * NTHR + tid; idx < NTOK * 8; idx += C.G * NTHR) {
        const int row = idx >> 3, i = idx & 7;
        const double inv = (i == 0) ? 1.0 : (i == 1) ? 0.19392274474868576 : (i == 2) ? 0.03760603093086393 : (i == 3) ? 0.007292664737217109 :
                           (i == 4) ? 0.001414213562373095 : (i == 5) ? 0.0002742481756762073 : (i == 6) ? 5.318295896944988e-05 : 1.031338537721246e-05;
        const double rev = (double)pos[row] * inv * 0.15915494309189535;
        const float fr = (float)(rev - __builtin_rint(rev));
        tab[(size_t)row * 16 + i] = __builtin_amdgcn_cosf(fr); tab[(size_t)row * 16 + 8 + i] = __builtin_amdgcn_sinf(fr);
    }
}

template <int G>
__device__ __forceinline__ void pool_item(const bf16_t* INP, bf16_t* Y, const bf16_t* PWT, const float* pscale, int rb, int r32, int hi) {
    constexpr int W2 = 1 << G;
    const int row = rb * 32 + r32, s = row & (SEQ - 1), b0 = row - s;
    const int lo = (s - W2 < 0) ? 0 : s - W2, hi_ = (s + W2 > SEQ) ? SEQ : s + W2;
    const float rc = 1.0f / (float)(hi_ - lo);
    f32x16 a0 = f32x16{}, a1 = f32x16{};
#pragma unroll
    for (int ks = 0; ks < 4; ++ks) {
        const int ch = G * 64 + ks * 16 + hi * 8;
        u32x4 w[2 * W2];
#pragma unroll
        for (int jj = 0; jj < 2 * W2; ++jj) { int j = s - W2 + jj; j = j < 0 ? 0 : (j > SEQ - 1 ? SEQ - 1 : j); w[jj] = *(const u32x4*)(INP + (size_t)(b0 + j) * INW + ch); }
        float sum[8];
#pragma unroll
        for (int e = 0; e < 8; ++e) sum[e] = 0.f;
#pragma unroll
        for (int jj = 0; jj < 2 * W2; ++jj) { const int j = s - W2 + jj; const float m = (j >= 0 && j < SEQ) ? 1.f : 0.f;
            sum[0] += m * bf_lo(w[jj].x); sum[1] += m * bf_hi(w[jj].x); sum[2] += m * bf_lo(w[jj].y); sum[3] += m * bf_hi(w[jj].y);
            sum[4] += m * bf_lo(w[jj].z); sum[5] += m * bf_hi(w[jj].z); sum[6] += m * bf_lo(w[jj].w); sum[7] += m * bf_hi(w[jj].w); }
        const u32x4 uw = w[W2];
        const float u[8] = {bf_lo(uw.x), bf_hi(uw.x), bf_lo(uw.y), bf_hi(uw.y), bf_lo(uw.z), bf_hi(uw.z), bf_lo(uw.w), bf_hi(uw.w)};
        u32x4 pa; pa.x = cvt_pk_bf16(sum[0] * rc - u[0], sum[1] * rc - u[1]); pa.y = cvt_pk_bf16(sum[2] * rc - u[2], sum[3] * rc - u[3]);
        pa.z = cvt_pk_bf16(sum[4] * rc - u[4], sum[5] * rc - u[5]); pa.w = cvt_pk_bf16(sum[6] * rc - u[6], sum[7] * rc - u[7]);
        const bf16x8 af = *reinterpret_cast<bf16x8*>(&pa);
        const bf16x8 w0 = *reinterpret_cast<const bf16x8*>(PWT + (size_t)G * 4096 + (size_t)r32 * 64 + ks * 16 + hi * 8);
        const bf16x8 w1 = *reinterpret_cast<const bf16x8*>(PWT + (size_t)G * 4096 + (size_t)(32 + r32) * 64 + ks * 16 + hi * 8);
        a0 = __builtin_amdgcn_mfma_f32_32x32x16_bf16(af, w0, a0, 0, 0, 0);
        a1 = __builtin_amdgcn_mfma_f32_32x32x16_bf16(af, w1, a1, 0, 0, 0);
    }
    const float sc0 = pscale[G * 64 + r32], sc1 = pscale[G * 64 + 32 + r32];
#pragma unroll
    for (int r = 0; r < 16; ++r) { bf16_t* yp = Y + (size_t)(rb * 32 + att::crow(r, hi)) * DM + G * 64 + r32;
        yp[0] = (bf16_t)(cvt_pk_bf16(a0[r] * sc0, 0.f) & 0xffffu); yp[32] = (bf16_t)(cvt_pk_bf16(a1[r] * sc1, 0.f) & 0xffffu); }
}
__device__ __forceinline__ void pool_phase(const Ctx& C, const Args& A, int l) {
    const bf16_t* INP = (const bf16_t*)(C.ws + WS_BIG); bf16_t* Y = (bf16_t*)(C.ws + WS_Y);
    const bf16_t* PWT = (const bf16_t*)(C.ws + WS_W + W_POOL);
    const float* pscale = (const float*)A.in[10] + (size_t)l * 256;
    const int lane = opaque_tid() & 63, r32 = lane & 31, hi = lane >> 5;
    for (int it = C.gw, k = 0; it < (NTOK / 32) * 4; it += C.NGW, ++k) {
        const int rb = it >> 2, g = (it + k) & 3;
        if (g == 0) pool_item<0>(INP, Y, PWT, pscale, rb, r32, hi);
        else if (g == 1) pool_item<1>(INP, Y, PWT, pscale, rb, r32, hi);
        else if (g == 2) pool_item<2>(INP, Y, PWT, pscale, rb, r32, hi);
        else pool_item<3>(INP, Y, PWT, pscale, rb, r32, hi);
    }
}

__device__ __forceinline__ void da_unit(const Ctx& C, const Args& A, char* lds, int l, int b, int h, int qb, float lam) {
    const bf16_t* INP = (const bf16_t*)(C.ws + WS_BIG); bf16_t* Y = (bf16_t*)(C.ws + WS_Y); float* OT = (float*)(C.ws + WS_OT);
    const size_t rowb = (size_t)b * SEQ;
#pragma unroll 1
    for (int c = 0; c < 2; ++c) {
        f32x16 o[4]; float l_reg; float rli[16];
        {
            const int wid0 = __builtin_amdgcn_readfirstlane(threadIdx.x >> 6);
            const size_t row0 = rowb + (size_t)qb * 256 + wid0 * 32;
            const bf16_t* Vh = INP + rowb * INW + 1280 + h * 128;
            const bf16_t* Qw = INP + row0 * INW + 256 + (h * 2 + c) * 64; const bf16_t* Kh = INP + rowb * INW + 768 + (h * 2 + c) * 64;
            att::attn_pass<128, INW, INW, INW>(Qw, Kh, Vh, SEQ / 64, lds, o, l_reg);
        }
        att::row_rcp<128>(lds, l_reg, rli);
        int tid = threadIdx.x; asm volatile("" : "+v"(tid));
        const int wid = tid >> 6, lane = tid & 63, r32 = lane & 31, hi = lane >> 5;
        const size_t row0 = rowb + (size_t)qb * 256 + wid * 32;
        float* OTw = OT + (row0 + 4 * hi) * 512 + h * 128 + r32;
        if (c == 0) {
#pragma unroll
            for (int r = 0; r < 16; ++r) {
#pragma unroll
                for (int d0 = 0; d0 < 4; ++d0) OTw[((r & 3) + 8 * (r >> 2)) * 512 + d0 * 32] = o[d0][r] * rli[r]; }
        } else {
            const float* sg = (const float*)A.in[15] + (size_t)l * 128;
            const float lam_init = 0.8f - 0.6f * expf(-0.3f * (float)l);
            float gcol[4];
#pragma unroll
            for (int d0 = 0; d0 < 4; ++d0) gcol[d0] = sg[d0 * 32 + r32] * (1.0f - lam_init);
            bf16_t* Yw = Y + (row0 + 4 * hi) * DM + 256 + h * 128 + r32;
#pragma unroll
            for (int r = 0; r < 16; ++r) { float ss = 0.f; float v[4];
#pragma unroll
                for (int d0 = 0; d0 < 4; ++d0) { v[d0] = OTw[((r & 3) + 8 * (r >> 2)) * 512 + d0 * 32] - lam * (o[d0][r] * rli[r]); ss += v[d0] * v[d0]; }
#pragma unroll
                for (int off = 1; off < 32; off <<= 1) ss += __shfl_xor(ss, off);
                const float rs = 1.0f / sqrtf(ss * (1.f / 128.f) + NORM_EPS);
#pragma unroll
                for (int d0 = 0; d0 < 4; ++d0) Yw[((r & 3) + 8 * (r >> 2)) * DM + d0 * 32] = (bf16_t)(cvt_pk_bf16(v[d0] * rs * gcol[d0], 0.f) & 0xffffu);
                asm volatile("" ::: "memory"); }
        }
    }
}
__device__ __forceinline__ void ca_unit(const Ctx& C, char* lds, int b, int h, int qb) {
    const bf16_t* INP = (const bf16_t*)(C.ws + WS_BIG); bf16_t* Y = (bf16_t*)(C.ws + WS_Y); const bf16_t* KVM = (const bf16_t*)(C.ws + WS_KVM);
    const int tid = opaque_tid(), wid = tid >> 6, lane = tid & 63, r32 = lane & 31, hi = lane >> 5;
    const size_t row0 = (size_t)b * SEQ + (size_t)qb * 256 + wid * 32;
    const bf16_t* Qw = INP + row0 * INW + 1792 + h * 64;
    const bf16_t* Kh = KVM + (size_t)b * NMEM * 512 + h * 64; const bf16_t* Vh = Kh + 256;
    f32x16 o[2]; float l_reg; float rli[16];
    att::attn_pass<64, INW, 512, 512>(Qw, Kh, Vh, NMEM / 64, lds, o, l_reg);
    att::row_rcp<64>(lds, l_reg, rli);
#pragma unroll
    for (int r = 0; r < 16; ++r) { bf16_t* yp = Y + (row0 + att::crow(r, hi)) * DM + 768 + h * 64 + r32;
#pragma unroll
        for (int d0 = 0; d0 < 2; ++d0) yp[d0 * 32] = (bf16_t)(cvt_pk_bf16(o[d0][r] * rli[r], 0.f) & 0xffffu); }
}


#define XB_TMO      128
#define XB_XCNT(j)  (256  + 64 * (j))
#define XB_XSUB(j)  (1280 + 64 * (j))
#define XB_XGEN(j)  (2304 + 64 * (j))
#define XB_TOP      3328
#define XB_TOPGEN   3392
#define XCD_BAR_WORDS 3456
#define XB_SPIN_CAP (1u << 20)
__device__ __forceinline__ unsigned xb_ld(unsigned* p)              { return __hip_atomic_load(p, __ATOMIC_RELAXED, __HIP_MEMORY_SCOPE_AGENT); }
__device__ __forceinline__ unsigned xb_add(unsigned* p, unsigned v) { return __hip_atomic_fetch_add(p, v, __ATOMIC_RELAXED, __HIP_MEMORY_SCOPE_AGENT); }
__device__ __forceinline__ unsigned xb_xcc_id() { return (unsigned)__builtin_amdgcn_s_getreg((3 << 11) | 20) & 0xFu; }
#define XB_SPIN(cond, bar) do { unsigned _sp = 0; while (cond) { __builtin_amdgcn_s_sleep(1); \
    if ((++_sp & 255u) == 0u) { if (xb_ld(&(bar)[XB_TMO])) break; if (_sp > XB_SPIN_CAP) { atomicAdd(&(bar)[XB_TMO], 1u); break; } } } } while (0)
struct XcdBarrier { unsigned* bar; unsigned x; volatile LAS unsigned* st; };
__device__ __forceinline__ XcdBarrier xcd_barrier_post(unsigned* bar, volatile LAS unsigned* st) {
    XcdBarrier b; b.bar = bar; b.x = xb_xcc_id(); b.st = st;
    if (threadIdx.x == 0) (void)xb_add(&bar[XB_XCNT(b.x)], 1u);
    return b;
}
__device__ __forceinline__ void xcd_barrier_complete(unsigned* bar, unsigned x, unsigned& nloc, unsigned& nx) {
    const unsigned G = gridDim.x * gridDim.y * gridDim.z;
    unsigned sum, cnt, mine, sp = 0u;
    for (;;) {
        sum = 0u; cnt = 0u; mine = 0u;
#pragma unroll
        for (unsigned j = 0; j < 16; ++j) { const unsigned c = xb_ld(&bar[XB_XCNT(j)]); sum += c; cnt += (c > 0u) ? 1u : 0u; mine = (j == x) ? c : mine; }
        if (sum == G) break;
        __builtin_amdgcn_s_sleep(1);
        if ((++sp & 255u) == 0u) { if (xb_ld(&bar[XB_TMO])) break; if (sp > XB_SPIN_CAP) { atomicAdd(&bar[XB_TMO], 1u); break; } }
    }
    nloc = mine > 0u ? mine : 1u; nx = cnt > 0u ? cnt : 1u;
}
__device__ __forceinline__ void xcd_barrier(const XcdBarrier& b) {
    asm volatile("s_waitcnt vmcnt(0)" ::: "memory");
    __syncthreads();
    if (threadIdx.x == 0) {
        unsigned* bar = b.bar;
        __builtin_amdgcn_s_waitcnt(0);
        unsigned nloc = b.st[0], nx = b.st[1];
        if (nloc == 0u) { xcd_barrier_complete(bar, b.x, nloc, nx); b.st[0] = nloc; b.st[1] = nx; }
        const unsigned old = xb_add(&bar[XB_XSUB(b.x)], 1u);
        const unsigned gen = old / nloc;
        if (old + 1u == (gen + 1u) * nloc) {
            __builtin_amdgcn_fence(__ATOMIC_RELEASE, "agent");
            asm volatile("s_waitcnt vmcnt(0)" ::: "memory");
            const unsigned og = xb_add(&bar[XB_TOP], 1u);
            const unsigned tg = og / nx;
            if (og + 1u == (tg + 1u) * nx) xb_add(&bar[XB_TOPGEN], 1u);
            else XB_SPIN(xb_ld(&bar[XB_TOPGEN]) == tg, bar);
            __builtin_amdgcn_fence(__ATOMIC_ACQUIRE, "agent");
            xb_add(&bar[XB_XGEN(b.x)], 1u);
            asm volatile("s_waitcnt vmcnt(0)" ::: "memory");
        } else {
            XB_SPIN(xb_ld(&bar[XB_XGEN(b.x)]) == gen, bar);
            __builtin_amdgcn_fence(__ATOMIC_ACQUIRE, "agent");
            asm volatile("s_waitcnt vmcnt(0)" ::: "memory");
        }
    }
    __syncthreads();
}

constexpr int LDS_BYTES = pg8::STAGE_BYTES + 256 + 4096 + 1024;

enum { K_SWIGLU = 0, K_STORE = 1, K_NORM = 2, K_ROPE = 3, K_ATT = 4, K_GATE = 5, K_FNORM = 6, K_NONE = 7 };
constexpr int NOPS = 15;

__global__ void __launch_bounds__(NTHR) mega_fwd(Args args) {
    extern __shared__ __attribute__((aligned(16))) unsigned char lds[];
    cg::grid_group grid = cg::this_grid();
    Ctx C; C.wave = __builtin_amdgcn_readfirstlane(threadIdx.x >> 6);
    C.G = gridDim.x; { const int bx = blockIdx.x; C.vcu = (C.G % 8 == 0) ? (bx % 8) * (C.G / 8) + bx / 8 : bx; }
    C.gw = C.vcu * NWAVES + C.wave; C.NGW = C.G * NWAVES; C.ws = args.ws;
    LAS unsigned char* ldsl = (LAS unsigned char*)lds;
    unsigned char* ws = args.ws;
    bf16_t* H = (bf16_t*)(ws + WS_H); bf16_t* Y = (bf16_t*)(ws + WS_Y); bf16_t* T1 = (bf16_t*)(ws + WS_T1);
    bf16_t* BIG = (bf16_t*)(ws + WS_BIG); bf16_t* MRG = (bf16_t*)(ws + WS_MRG); bf16_t* KVM = (bf16_t*)(ws + WS_KVM); bf16_t* MEMN = (bf16_t*)(ws + WS_MEMN);
    const char* Wb = (const char*)(ws + WS_W);
    const float* x_in = (const float*)args.in[0];
    float* X = args.out;
    const int bid = (int)blockIdx.x;

    volatile LAS unsigned* bst = (volatile LAS unsigned*)(ldsl + pg8::STAGE_BYTES);
    if (threadIdx.x < 2) bst[threadIdx.x] = 0u;
    if (blockIdx.x == 0) { for (int i = threadIdx.x; i < XCD_BAR_WORDS; i += NTHR) __hip_atomic_store((unsigned*)ws + i, 0u, __ATOMIC_RELAXED, __HIP_MEMORY_SCOPE_AGENT); }
    if (blockIdx.x == 1) { for (int i = threadIdx.x; i < 128; i += NTHR) __hip_atomic_store((unsigned*)(ws + WS_XCNT) + 64 * i, 0u, __ATOMIC_RELAXED, __HIP_MEMORY_SCOPE_AGENT); }
    if (EN_CONV) convert_layer(C, args, ldsl, 0);
    if (EN_CONV) rope_table(C, args);
    float* RSTD = (float*)(ws + WS_RSTD);
    if (EN_NORM) norm_phase(C, x_in, H, nullptr, nullptr, 0.f, RSTD, nullptr);
    grid.sync();
    const XcdBarrier xbar = xcd_barrier_post((unsigned*)ws, bst);

#pragma unroll 1
    for (int step = 0; step < DEPTH * NOPS; ++step) {
        int l = step / NOPS, op = step - l * NOPS;
        asm volatile("" : "+s"(l), "+s"(op));
        int kind; bool sync = true;
        if (op == 0 || op == 12) kind = K_SWIGLU; else if (op == 3 || op == 11) kind = K_NONE; else if (op == 14) kind = K_NORM; else if (op == 4) kind = K_ROPE;
        else if (op == 5) kind = K_ATT; else if (op == 9) kind = K_GATE; else if (op == 2 || op == 10 || op == 13) kind = K_FNORM; else kind = K_STORE;
        if (op == 0 || op == 6 || op == 7 || op == 8 || op == 3 || op == 11) sync = false;
        if ((op == 13 || op == 14) && l == DEPTH - 1) sync = false;
        int reps = 1;
#if defined(PROBE_DUP_ATT)
        if (op == 5) reps = 2;
#endif
#if defined(PROBE_DUP_FFN)
        if (op == 0 || op == 2 || op == 12 || op == 13) reps = 2;
#endif
#if defined(PROBE_DUP_MIX)
        if (op == 4 || op == 6 || op == 7 || op == 8 || op == 10) reps = 2;
#endif
#pragma unroll 1
        for (int rep = 0; rep < reps; ++rep) {

        if (kind == K_SWIGLU) {
            pg8::Gemm g{H, (const bf16_t*)(Wb + (op == 0 ? W_UP1 : W_UP2)), DM, DM, NTOK, NUP, DM}; pg8::StaticOrder S; S.init(NTOK, NUP, C.G, bid);
            pg8::EpiSwiglu E{BIG, FF, RSTD}; if (EN_GEMM && EN_G1) pg8::gemm_phase<pg8::EpiSwiglu, true>(ldsl, g, S, E);
        } else if (kind == K_STORE) {
            pg8::Gemm g; pg8::EpiStore E;
            if (op == 1)       { g = pg8::Gemm{MEMN, (const bf16_t*)(Wb + W_KV), DM, DM, NBATCH * NMEM, 512, DM}; E = pg8::EpiStore{KVM, 512}; }
            else if (op == 6)  { g = pg8::Gemm{Y, (const bf16_t*)(Wb + W_BRP), DM, 256, NTOK, DM, 256}; E = pg8::EpiStore{BIG, 3072}; }
            else if (op == 7)  { g = pg8::Gemm{Y + 256, (const bf16_t*)(Wb + W_BRD), DM, 512, NTOK, DM, 512}; E = pg8::EpiStore{BIG + 1024, 3072}; }
            else               { g = pg8::Gemm{Y + 768, (const bf16_t*)(Wb + W_BRC), DM, 256, NTOK, DM, 256}; E = pg8::EpiStore{BIG + 2048, 3072}; }
            pg8::StaticOrder S; S.init(g.M, g.N, C.G, bid);
            if (EN_GEMM && EN_GS) pg8::gemm_phase<pg8::EpiStore, true>(ldsl, g, S, E);
        } else if (kind == K_ROPE) {
            pg8::Gemm g{H, (const bf16_t*)(Wb + W_IN), DM, DM, NTOK, INW, DM}; pg8::StaticOrder S; S.init(NTOK, INW, C.G, bid);
            pg8::EpiRope E{BIG, INW, (const float*)(ws + WS_ROPE), RSTD}; if (EN_GEMM && EN_GR) pg8::gemm_phase<pg8::EpiRope, true>(ldsl, g, S, E);
        } else if (kind == K_GATE) {
            pg8::Gemm g{H, (const bf16_t*)(Wb + W_GATE), DM, DM, NTOK, 3072, DM}; pg8::GateOrder S; S.base.init(NTOK, DM, C.G, bid);
            pg8::EpiGate E{BIG, MRG, (const float*)args.in[19] + (size_t)l * 3072, RSTD, T1}; if (EN_GEMM && EN_GG) pg8::gemm_phase<pg8::EpiGate, true>(ldsl, g, S, E);
#if defined(PROBE_GATE_STORE)
            { pg8::EpiStore E2{Y, DM}; pg8::gemm_phase<pg8::EpiStore, true>(ldsl, g, S, E2); }
#endif
        } else if (kind == K_FNORM) {
            pg8::Gemm g;
            if (op == 2)       g = pg8::Gemm{BIG, (const bf16_t*)(Wb + W_DN1), FF, FF, NTOK, DM, FF};
            else if (op == 10) g = pg8::Gemm{MRG, (const bf16_t*)(Wb + W_OUT3), DM, DM, NTOK, DM, DM};
            else               g = pg8::Gemm{BIG, (const bf16_t*)(Wb + W_DN2), FF, FF, NTOK, DM, FF};
            const float* gpost = ((op == 2) ? (const float*)args.in[6] : (op == 10) ? (const float*)args.in[24] : (const float*)args.in[28]) + (size_t)l * DM;
            const bool last = (op == 13 && l + 1 == DEPTH);
            const unsigned seam = (unsigned)(l * 3 + (op == 2 ? 0 : op == 10 ? 1 : 2));
            pg8::PanelSsq x1{(float*)(ws + WS_XSLOT), (unsigned*)(ws + WS_XCNT), 16u * (seam + 1u)};
            pg8::EpiNorm E{H, last ? X : nullptr, gpost, (op == 10) ? 1.0f : 0.5f, RSTD, x1};
            pg8::StaticOrder S; S.init(NTOK, DM, C.G, bid);
            if (EN_GEMM) pg8::gemm_phase<pg8::EpiNorm, true>(ldsl, g, S, E);
        } else if (kind == K_NORM) {
            if (l + 1 < DEPTH) { if (EN_CONV) convert_layer(C, args, ldsl, l + 1); }
#if defined(PROBE_DUP_CONV)
            if (l + 1 < DEPTH) { convert_layer(C, args, ldsl, l + 1); convert_layer(C, args, ldsl, l + 1); }
#endif
        } else if (kind == K_NONE) {
        } else {
            const float* q1 = (const float*)args.in[11] + l * 64; const float* k1 = (const float*)args.in[12] + l * 64;
            const float* q2 = (const float*)args.in[13] + l * 64; const float* k2 = (const float*)args.in[14] + l * 64;
            const int lane_ = opaque_tid() & 63;
            float d1 = q1[lane_] * k1[lane_], d2 = q2[lane_] * k2[lane_];
            d1 = wave_sum(d1); d2 = wave_sum(d2);
            const float lam = __uint_as_float(__builtin_amdgcn_readfirstlane(__float_as_uint(expf(d1) - expf(d2) + (0.8f - 0.6f * expf(-0.3f * (float)l)))));
#pragma unroll 1
            for (int i = 0; i < 2; ++i) { const int u = C.vcu * 2 + i; if (EN_DA && u < NBATCH * 4 * 32) da_unit(C, args, (char*)lds, l, u >> 7, (u >> 5) & 3, u & 31, lam); }
#pragma unroll 1
            for (int i = 0; i < 2; ++i) { const int u = C.vcu * 2 + i; if (EN_CA && u < NBATCH * 4 * 32) ca_unit(C, (char*)lds, u >> 7, (u >> 5) & 3, u & 31); }
            if (EN_POOL) pool_phase(C, args, l);
        }
        }
        if (sync) xcd_barrier(xbar);
#if defined(PROBE_DUP_SYNC)
        if (sync) { xcd_barrier(xbar); xcd_barrier(xbar); xcd_barrier(xbar); xcd_barrier(xbar); }
#endif
    }
}

extern "C" void kernel_launch(void* const* d_in, const int* in_sizes, int n_in, void* d_out, int out_size, void* d_ws, size_t ws_size, hipStream_t stream) {
    static int grid = 0;
    if (grid == 0) {
        if (n_in != 29 || in_sizes[0] != NTOK * DM || out_size != NTOK * DM || ws_size < WS_TOTAL) {
            fprintf(stderr, "kernel_launch: unexpected shapes: n_in %d in0 %d out %d ws %zu (need %zu)\n", n_in, n_in > 0 ? in_sizes[0] : -1, out_size, ws_size, (size_t)WS_TOTAL); grid = -1; return; }
        int dev = 0, cus = 0, per_cu = 0;
        hipGetDevice(&dev); hipDeviceGetAttribute(&cus, hipDeviceAttributeMultiprocessorCount, dev);
        if (hipFuncSetAttribute((const void*)mega_fwd, hipFuncAttributeMaxDynamicSharedMemorySize, LDS_BYTES) != hipSuccess) { fprintf(stderr, "kernel_launch: hipFuncSetAttribute failed\n"); grid = -1; return; }
        if (hipOccupancyMaxActiveBlocksPerMultiprocessor(&per_cu, (const void*)mega_fwd, NTHR, LDS_BYTES) != hipSuccess || per_cu < 1) { fprintf(stderr, "kernel_launch: occupancy query says %d\n", per_cu); per_cu = 1; }
        (void)hipGetLastError();
        grid = cus;
        fprintf(stderr, "kernel_launch: grid %d (cus %d, per_cu %d)\n", grid, cus, per_cu);
    }
    if (grid < 0) return;
    Args a{};
    for (int i = 0; i < 29; ++i) a.in[i] = d_in[i];
    a.out = (float*)d_out; a.ws = (unsigned char*)d_ws;
    void* kargs[] = {&a};
    hipError_t e = hipLaunchCooperativeKernel((const void*)mega_fwd, dim3(grid), dim3(NTHR), kargs, LDS_BYTES, stream);
    if (e != hipSuccess) fprintf(stderr, "kernel_launch: cooperative launch failed: %s (grid %d)\n", hipGetErrorString(e), grid);
}
```

```cpp
#include <hip/hip_runtime.h>
#include <hip/hip_cooperative_groups.h>
#include <cstdio>
#include <cstdint>
namespace cg = cooperative_groups;
#ifndef EN_G1
#define EN_G1 1
#endif
#ifndef EN_GS
#define EN_GS 1
#endif
#ifndef EN_GR
#define EN_GR 1
#endif
#ifndef EN_GG
#define EN_GG 1
#endif
#ifndef EN_GEMM
#define EN_GEMM 1
#endif
#ifndef EN_DA
#define EN_DA 1
#endif
#ifndef EN_CA
#define EN_CA 1
#endif
#ifndef EN_POOL
#define EN_POOL 1
#endif
#ifndef EN_NORM
#define EN_NORM 1
#endif
#ifndef EN_CONV
#define EN_CONV 1
#endif

#define LAS __attribute__((address_space(3)))
typedef unsigned short bf16_t;
typedef short bf16x8 __attribute__((ext_vector_type(8)));
typedef short s16x4 __attribute__((ext_vector_type(4)));
typedef float f32x4 __attribute__((ext_vector_type(4)));
typedef float f32x2 __attribute__((ext_vector_type(2)));
typedef float f32x16 __attribute__((ext_vector_type(16)));
typedef unsigned u32x4 __attribute__((ext_vector_type(4)));
typedef unsigned u32x2 __attribute__((ext_vector_type(2)));

constexpr int NTOK = 32768, DM = 1024, SEQ = 8192, NBATCH = 4, FF = 2816, NUP = 5632, INW = 2048, NMEM = 256, DEPTH = 4;
constexpr float NORM_EPS = 1e-6f;
constexpr int NWAVES = 8, NTHR = 512;

constexpr size_t MiB = 1u << 20;
constexpr size_t WS_XCNT = 64 * 1024;
constexpr size_t WS_XSLOT = 6 * MiB;
constexpr size_t WS_RSTD = 7 * MiB;
constexpr size_t WS_ROPE = 1 * MiB;
constexpr size_t WS_MEMN = 3 * MiB;
constexpr size_t WS_KVM  = 5 * MiB;
constexpr size_t WS_W    = 8 * MiB;
constexpr size_t W_UP1 = 0, W_DN1 = W_UP1 + (size_t)NUP * DM * 2, W_IN = W_DN1 + (size_t)DM * FF * 2, W_GATE = W_IN + (size_t)INW * DM * 2,
                 W_BRP = W_GATE + (size_t)3072 * DM * 2, W_BRD = W_BRP + (size_t)DM * 256 * 2, W_BRC = W_BRD + (size_t)DM * 512 * 2,
                 W_OUT3 = W_BRC + (size_t)DM * 256 * 2, W_UP2 = W_OUT3 + (size_t)DM * 3072 * 2, W_DN2 = W_UP2 + (size_t)NUP * DM * 2,
                 W_KV = W_DN2 + (size_t)DM * FF * 2, W_POOL = W_KV + (size_t)512 * DM * 2, W_END = W_POOL + 4 * 64 * 64 * 2;
static_assert(WS_W + W_END <= 64 * MiB, "weights region");
constexpr size_t WS_H   = 64 * MiB;
constexpr size_t WS_Y   = 128 * MiB;
constexpr size_t WS_T1  = 192 * MiB;
constexpr size_t WS_BIG = 256 * MiB;
constexpr size_t WS_OT  = WS_BIG + 128 * MiB;
constexpr size_t WS_MRG = 448 * MiB;
constexpr size_t WS_TOTAL = 512 * MiB;

__device__ __forceinline__ unsigned cvt_pk_bf16(float lo, float hi) { unsigned r; asm volatile("v_cvt_pk_bf16_f32 %0, %1, %2" : "=v"(r) : "v"(lo), "v"(hi)); return r; }
__device__ __forceinline__ float bf_lo(unsigned u) { return __uint_as_float(u << 16); }
__device__ __forceinline__ float bf_hi(unsigned u) { return __uint_as_float(u & 0xffff0000u); }
__device__ __forceinline__ float wave_sum(float v) {
#pragma unroll
    for (int o = 1; o < 64; o <<= 1) v += __shfl_xor(v, o);
    return v;
}
__device__ __forceinline__ float sigmoidf_fast(float x) { return __builtin_amdgcn_rcpf(1.0f + __builtin_amdgcn_exp2f(-1.4426950408889634f * x)); }

namespace pg8 {
constexpr int BM = 256, BK = 64, HALF = 128, HTB = HALF * BK * 2, STAGE_BYTES = 8 * HTB, NXCD = 8, WGM = 8;
__host__ __device__ __forceinline__ int lds_byte(int r, int c) { const int st = (r >> 4) * 2 + (c >> 5), rr = r & 15, cc = c & 31, ob = rr * 64 + cc * 2; return st * 1024 + (ob ^ (((ob >> 9) & 1) << 5)); }
__host__ __device__ __forceinline__ void stage_rc(int b, int& R, int& C) { const int st = b / 1024, sb = b % 1024, swz = sb ^ (((sb >> 9) & 1) << 5); R = (st >> 1) * 16 + swz / 64; C = (st & 1) * 32 + (swz % 64) / 2; }
__host__ __device__ __forceinline__ int perm32(int rho) { const int n = rho >> 4, i = rho & 15; return 8 * (i >> 2) + 4 * n + (i & 3); }

struct Unit { int pm, pn; };
struct Gemm { const bf16_t* A; const bf16_t* Bt; int lda, ldb, M, N, K; };

struct StaticOrder {
    int nM, nN, nwg, G, c;
    __device__ void init(int M, int N, int G_, int c_) { nM = M / BM; nN = N / BM; nwg = nM * nN; G = G_; c = c_; }
    __device__ bool next(int i, Unit& u) const {
        const long L = (long)i * G + c; if (L >= nwg) return false;
        int wgid = (int)L; { const int q = nwg / NXCD, r = nwg % NXCD, xcd = wgid % NXCD, off = wgid / NXCD; wgid = (xcd < r ? xcd * (q + 1) : r * (q + 1) + (xcd - r) * q) + off; }
        const int nig = WGM * nN, gid = wgid / nig, fm = gid * WGM, gsz = (nM - fm) < WGM ? (nM - fm) : WGM;
        u.pm = fm + ((wgid % nig) % gsz); u.pn = (wgid % nig) / gsz; return true;
    }
};

struct EpiStore {
    static constexpr bool FUSED = false;
    bf16_t* O; int ldc;
    __device__ __forceinline__ void prefetch(const Unit&, int, int, float (&)[2][4]) const {}
    __device__ __forceinline__ void operator()(const f32x4 (&acc)[2][2][4][2], const Unit& u, int wr, int wc, int fr, int fq, const float (&)[2][4]) const {
        const int row0 = u.pm * BM + wr * 64 + fr, col0 = u.pn * BM + wc * 32 + 8 * fq;
#pragma unroll
        for (int ai = 0; ai < 2; ++ai)
#pragma unroll
            for (int m = 0; m < 4; ++m) { bf16_t* rowp = O + (size_t)(row0 + ai * HALF + m * 16) * ldc + col0;
#pragma unroll
                for (int bj = 0; bj < 2; ++bj) { const f32x4 v0 = acc[ai][bj][m][0], v1 = acc[ai][bj][m][1];
                    u32x4 w; w.x = cvt_pk_bf16(v0[0], v0[1]); w.y = cvt_pk_bf16(v0[2], v0[3]); w.z = cvt_pk_bf16(v1[0], v1[1]); w.w = cvt_pk_bf16(v1[2], v1[3]);
                    *(u32x4*)(rowp + bj * HALF) = w; } }
    }
};
struct EpiSwiglu {
    static constexpr bool FUSED = false;
    bf16_t* O; int ldc; const float* rstd;
    __device__ __forceinline__ void prefetch(const Unit& u, int wr, int fr, float (&rf)[2][4]) const {
        const int row0 = u.pm * BM + wr * 64 + fr;
#pragma unroll
        for (int ai = 0; ai < 2; ++ai)
#pragma unroll
            for (int m = 0; m < 4; ++m) { const f32x4 q4 = *(const f32x4*)(rstd + (size_t)(row0 + ai * HALF + m * 16) * 4); rf[ai][m] = 1.0f / sqrtf(((q4[0] + q4[1]) + (q4[2] + q4[3])) * (1.f / DM) + NORM_EPS); }
    }
    __device__ __forceinline__ void operator()(const f32x4 (&acc)[2][2][4][2], const Unit& u, int wr, int wc, int fr, int fq, const float (&rsv)[2][4]) const {
        const int row0 = u.pm * BM + wr * 64 + fr, col0 = u.pn * HALF + wc * 32 + 8 * fq;
#pragma unroll
        for (int ai = 0; ai < 2; ++ai)
#pragma unroll
            for (int m = 0; m < 4; ++m) { bf16_t* rowp = O + (size_t)(row0 + ai * HALF + m * 16) * ldc + col0;
                const float rs = rsv[ai][m];
                float h[8];
#pragma unroll
                for (int n = 0; n < 2; ++n)
#pragma unroll
                    for (int e = 0; e < 4; ++e) { const float a = acc[ai][0][m][n][e] * rs, b = acc[ai][1][m][n][e] * rs; h[n * 4 + e] = a * sigmoidf_fast(a) * b; }
                u32x4 w; w.x = cvt_pk_bf16(h[0], h[1]); w.y = cvt_pk_bf16(h[2], h[3]); w.z = cvt_pk_bf16(h[4], h[5]); w.w = cvt_pk_bf16(h[6], h[7]);
                *(u32x4*)rowp = w; }
    }
};
struct EpiRope {
    static constexpr bool FUSED = false;
    bf16_t* O; int ldc; const float* tab; const float* rstd;
    __device__ __forceinline__ void prefetch(const Unit& u, int wr, int fr, float (&rf)[2][4]) const {
        const int row0 = u.pm * BM + wr * 64 + fr;
#pragma unroll
        for (int ai = 0; ai < 2; ++ai)
#pragma unroll
            for (int m = 0; m < 4; ++m) { const f32x4 q4 = *(const f32x4*)(rstd + (size_t)(row0 + ai * HALF + m * 16) * 4); rf[ai][m] = 1.0f / sqrtf(((q4[0] + q4[1]) + (q4[2] + q4[3])) * (1.f / DM) + NORM_EPS); }
    }
    __device__ __forceinline__ void operator()(const f32x4 (&acc)[2][2][4][2], const Unit& u, int wr, int wc, int fr, int fq, const float (&rsv)[2][4]) const {
        const int row0 = u.pm * BM + wr * 64 + fr, col0 = u.pn * BM + wc * 32 + 8 * fq;
#pragma unroll
        for (int bj = 0; bj < 2; ++bj) {
            const int cw = u.pn * BM + bj * HALF + wc * 32;
            const bool rot = (cw >= 256) && (cw < 1280) && ((cw & 63) == 0);
#pragma unroll
            for (int ai = 0; ai < 2; ++ai)
#pragma unroll
                for (int m = 0; m < 4; ++m) { const int row = row0 + ai * HALF + m * 16;
                    const float rs = rsv[ai][m];
                    f32x4 v0 = acc[ai][bj][m][0] * rs, v1 = acc[ai][bj][m][1] * rs;
                    if (rot) {
                        const f32x4 c0 = *(const f32x4*)(tab + (size_t)row * 16), c1 = *(const f32x4*)(tab + (size_t)row * 16 + 4);
                        const f32x4 s0 = *(const f32x4*)(tab + (size_t)row * 16 + 8), s1 = *(const f32x4*)(tab + (size_t)row * 16 + 12);
                        f32x4 o0, o1;
#pragma unroll
                        for (int e = 0; e < 4; ++e) { o0[e] = __shfl_xor(v0[e], 16); o1[e] = __shfl_xor(v1[e], 16); }
                        const float sg = (fq == 0) ? -1.f : 1.f;
                        if (fq < 2) { v0 = v0 * c0 + (o0 * s0) * sg; v1 = v1 * c1 + (o1 * s1) * sg; }
                    }
                    u32x4 w; w.x = cvt_pk_bf16(v0[0], v0[1]); w.y = cvt_pk_bf16(v0[2], v0[3]); w.z = cvt_pk_bf16(v1[0], v1[1]); w.w = cvt_pk_bf16(v1[2], v1[3]);
                    *(u32x4*)(O + (size_t)row * ldc + col0 + bj * HALF) = w; }
        }
    }
};

struct PanelSsq {
    float* slots;
    unsigned* cnt;
    unsigned target;
    __device__ __forceinline__ void run(float (&part)[2][4], const Unit& u, int wr, int wc, int fr, int fq, LAS float* P, LAS float* S, int tid) const {
#pragma unroll
        for (int ai = 0; ai < 2; ++ai)
#pragma unroll
            for (int m = 0; m < 4; ++m) { float v = part[ai][m]; v += __shfl_xor(v, 16); v += __shfl_xor(v, 32);
                if (fq == 0) P[(ai * HALF + wr * 64 + m * 16 + fr) * 4 + wc] = v; }
        asm volatile("s_waitcnt lgkmcnt(0)" ::: "memory"); __builtin_amdgcn_s_barrier(); asm volatile("" ::: "memory");
        if (tid < 256) {
            const float sv = (P[tid * 4 + 0] + P[tid * 4 + 1]) + (P[tid * 4 + 2] + P[tid * 4 + 3]);
            __hip_atomic_store(slots + ((size_t)(u.pm * BM + tid) * 4 + u.pn), sv, __ATOMIC_RELAXED, __HIP_MEMORY_SCOPE_AGENT);
            asm volatile("s_waitcnt vmcnt(0)" ::: "memory");
            if ((tid & 63) == 0) __hip_atomic_fetch_add(cnt + 64 * u.pm, 1u, __ATOMIC_RELAXED, __HIP_MEMORY_SCOPE_AGENT);
        }
        if (tid < 64) {
            unsigned sp = 0;
            while ((unsigned)__builtin_amdgcn_readfirstlane(__hip_atomic_load(cnt + 64 * u.pm, __ATOMIC_RELAXED, __HIP_MEMORY_SCOPE_AGENT)) < target) {
                __builtin_amdgcn_s_sleep(2); if (++sp > (1u << 22)) break; }
            __builtin_amdgcn_fence(__ATOMIC_ACQUIRE, "agent");
        }
        asm volatile("s_waitcnt vmcnt(0) lgkmcnt(0)" ::: "memory"); __builtin_amdgcn_s_barrier(); asm volatile("" ::: "memory");
        if (tid < 256) {
            const float* sl = slots + (size_t)(u.pm * BM + tid) * 4;
            const float t0 = __hip_atomic_load(sl + 0, __ATOMIC_RELAXED, __HIP_MEMORY_SCOPE_AGENT), t1 = __hip_atomic_load(sl + 1, __ATOMIC_RELAXED, __HIP_MEMORY_SCOPE_AGENT);
            const float t2 = __hip_atomic_load(sl + 2, __ATOMIC_RELAXED, __HIP_MEMORY_SCOPE_AGENT), t3 = __hip_atomic_load(sl + 3, __ATOMIC_RELAXED, __HIP_MEMORY_SCOPE_AGENT);
            S[tid] = (t0 + t1) + (t2 + t3);
        }
        asm volatile("s_waitcnt vmcnt(0) lgkmcnt(0)" ::: "memory"); __builtin_amdgcn_s_barrier(); asm volatile("" ::: "memory");
    }
};
struct EpiNorm {
    static constexpr bool FUSED = true;
    bf16_t* XB; float* Fout; const float* gpost; float scale; float* ssq2; PanelSsq x1;
    __device__ __forceinline__ void prefetch(const Unit&, int, int, float (&)[2][4]) const {}
    __device__ __forceinline__ void fused(f32x4 (&acc)[2][2][4][2], const Unit& u, int wr, int wc, int fr, int fq, LAS unsigned char* xl, int tid) const {
        LAS float* P = (LAS float*)xl; LAS float* S = (LAS float*)(xl + 4096);
        const int col0 = u.pn * BM + wc * 32 + 8 * fq;
        float part[2][4];
#pragma unroll
        for (int ai = 0; ai < 2; ++ai)
#pragma unroll
            for (int m = 0; m < 4; ++m) { float q = 0.f;
#pragma unroll
                for (int bj = 0; bj < 2; ++bj)
#pragma unroll
                    for (int n = 0; n < 2; ++n) { const f32x4 v = acc[ai][bj][m][n]; q += (v[0] * v[0] + v[1] * v[1]) + (v[2] * v[2] + v[3] * v[3]); }
                part[ai][m] = q; }
        u32x4 xv[4][2];
#pragma unroll
        for (int m = 0; m < 4; ++m) { const size_t off = (size_t)(u.pm * BM + wr * 64 + m * 16 + fr) * DM + col0;
#pragma unroll
            for (int bj = 0; bj < 2; ++bj) xv[m][bj] = *(const u32x4*)(XB + off + bj * HALF); }
        x1.run(part, u, wr, wc, fr, fq, P, S, tid);
        f32x4 gp[2][2];
#pragma unroll
        for (int bj = 0; bj < 2; ++bj)
#pragma unroll
            for (int n = 0; n < 2; ++n) gp[bj][n] = *(const f32x4*)(gpost + col0 + bj * HALF + 4 * n);
#pragma unroll
        for (int ai = 0; ai < 2; ++ai)
#pragma unroll
            for (int m = 0; m < 4; ++m) { const int rl = ai * HALF + wr * 64 + m * 16 + fr; const size_t off = (size_t)(u.pm * BM + rl) * DM + col0;
                const float rs = scale / sqrtf(S[rl] * (1.f / DM) + NORM_EPS); float q = 0.f;
#pragma unroll
                for (int bj = 0; bj < 2; ++bj) { const u32x4 w = (ai == 0) ? xv[m][bj] : *(const u32x4*)(XB + off + bj * HALF);
                    const f32x4 x0 = (f32x4){bf_lo(w.x), bf_hi(w.x), bf_lo(w.y), bf_hi(w.y)}, x1v = (f32x4){bf_lo(w.z), bf_hi(w.z), bf_lo(w.w), bf_hi(w.w)};
                    const f32x4 n0 = x0 + acc[ai][bj][m][0] * rs * gp[bj][0], n1 = x1v + acc[ai][bj][m][1] * rs * gp[bj][1];
                    q += ((n0[0] * n0[0] + n0[1] * n0[1]) + (n0[2] * n0[2] + n0[3] * n0[3])) + ((n1[0] * n1[0] + n1[1] * n1[1]) + (n1[2] * n1[2] + n1[3] * n1[3]));
                    if (Fout) { *(f32x4*)(Fout + off + bj * HALF) = n0; *(f32x4*)(Fout + off + bj * HALF + 4) = n1; }
                    else { u32x4 o; o.x = cvt_pk_bf16(n0[0], n0[1]); o.y = cvt_pk_bf16(n0[2], n0[3]); o.z = cvt_pk_bf16(n1[0], n1[1]); o.w = cvt_pk_bf16(n1[2], n1[3]); *(u32x4*)(XB + off + bj * HALF) = o; } }
                part[ai][m] = q; }
        if (Fout) return;
#pragma unroll
        for (int ai = 0; ai < 2; ++ai)
#pragma unroll
            for (int m = 0; m < 4; ++m) { float v = part[ai][m]; v += __shfl_xor(v, 16); v += __shfl_xor(v, 32);
                if (fq == 0) P[(ai * HALF + wr * 64 + m * 16 + fr) * 4 + wc] = v; }
        asm volatile("s_waitcnt lgkmcnt(0)" ::: "memory"); __builtin_amdgcn_s_barrier(); asm volatile("" ::: "memory");
        if (tid < 256) ssq2[(size_t)(u.pm * BM + tid) * 4 + u.pn] = (P[tid * 4 + 0] + P[tid * 4 + 1]) + (P[tid * 4 + 2] + P[tid * 4 + 3]);
        asm volatile("s_waitcnt lgkmcnt(0)" ::: "memory"); __builtin_amdgcn_s_barrier(); asm volatile("" ::: "memory");
    }
};

struct GateOrder {
    StaticOrder base;
    __device__ bool next(int i, Unit& u) const { const int j = i / 3, b = i - 3 * j; if (!base.next(j, u)) return false; u.pn += 4 * b; return true; }
};
struct EpiGate {
    static constexpr bool FUSED = false;
    const bf16_t* PG; bf16_t* MRG; const float* bias; const float* rstd;
    __device__ __forceinline__ void prefetch(const Unit& u, int wr, int fr, float (&rf)[2][4]) const {
        const int row0 = u.pm * BM + wr * 64 + fr;
#pragma unroll
        for (int ai = 0; ai < 2; ++ai)
#pragma unroll
            for (int m = 0; m < 4; ++m) { const f32x4 q4 = *(const f32x4*)(rstd + (size_t)(row0 + ai * HALF + m * 16) * 4); rf[ai][m] = 1.0f / sqrtf(((q4[0] + q4[1]) + (q4[2] + q4[3])) * (1.f / DM) + NORM_EPS); }
    }
    __device__ __forceinline__ void operator()(const f32x4 (&acc)[2][2][4][2], const Unit& u, int wr, int wc, int fr, int fq, const float (&rsv)[2][4]) const {
        const int row0 = u.pm * BM + wr * 64 + fr, col0 = u.pn * BM + wc * 32 + 8 * fq, mcol0 = (u.pn & 3) * BM + wc * 32 + 8 * fq;
        const bool first = (u.pn < 4);
#pragma unroll
        for (int bj = 0; bj < 2; ++bj) {
            const f32x4 b0 = *(const f32x4*)(bias + col0 + bj * HALF), b1 = *(const f32x4*)(bias + col0 + bj * HALF + 4);
#pragma unroll
            for (int ai = 0; ai < 2; ++ai)
#pragma unroll
                for (int m = 0; m < 4; ++m) { const size_t row = (size_t)(row0 + ai * HALF + m * 16);
                    const u32x4 pv = __builtin_nontemporal_load((const u32x4*)(PG + row * 3072 + col0 + bj * HALF));
                    bf16_t* mp = MRG + row * DM + mcol0 + bj * HALF;
                    u32x4 mo = (u32x4){0u, 0u, 0u, 0u}; if (!first) mo = *(const u32x4*)mp;
                    const float rs = rsv[ai][m];
                    const f32x4 v0 = acc[ai][bj][m][0] * rs + b0, v1 = acc[ai][bj][m][1] * rs + b1;
                    const float g0 = sigmoidf_fast(v0[0]) * bf_lo(pv.x) + bf_lo(mo.x), g1 = sigmoidf_fast(v0[1]) * bf_hi(pv.x) + bf_hi(mo.x);
                    const float g2 = sigmoidf_fast(v0[2]) * bf_lo(pv.y) + bf_lo(mo.y), g3 = sigmoidf_fast(v0[3]) * bf_hi(pv.y) + bf_hi(mo.y);
                    const float g4 = sigmoidf_fast(v1[0]) * bf_lo(pv.z) + bf_lo(mo.z), g5 = sigmoidf_fast(v1[1]) * bf_hi(pv.z) + bf_hi(mo.z);
                    const float g6 = sigmoidf_fast(v1[2]) * bf_lo(pv.w) + bf_lo(mo.w), g7 = sigmoidf_fast(v1[3]) * bf_hi(pv.w) + bf_hi(mo.w);
                    u32x4 w; w.x = cvt_pk_bf16(g0, g1); w.y = cvt_pk_bf16(g2, g3); w.z = cvt_pk_bf16(g4, g5); w.w = cvt_pk_bf16(g6, g7);
                    *(u32x4*)mp = w; }
        }
    }
};

template <class Epi, bool ALIGN_EPI, class Sched>
__device__ __forceinline__ void gemm_phase(LAS unsigned char* lds, const Gemm g, const Sched& S, const Epi& E) {
    int tid = threadIdx.x; asm volatile("" : "+v"(tid));
    const int wid = __builtin_amdgcn_readfirstlane(tid >> 6), lane = tid & 63, wr = wid >> 2, wc = wid & 3, fr = lane & 15, fq = lane >> 4;
    const int nt = g.K / BK;
    unsigned voffA[2], voffB[2];
#pragma unroll
    for (int i = 0; i < 2; ++i) { int R, C; stage_rc(tid * 16 + i * 8192, R, C); const int Rb = (R & ~31) + perm32(R & 31);
        voffA[i] = (unsigned)(R * g.lda + C) * 2u; voffB[i] = (unsigned)(Rb * g.ldb + C) * 2u; }
    const size_t kstep = (size_t)(BK * 2);
    const size_t hstepA = (size_t)HALF * g.lda * 2, hstepB = (size_t)HALF * g.ldb * 2;
    const size_t tstepA = 2 * hstepA, tstepB = 2 * hstepB;
    const unsigned ldsw = (unsigned)wid * 1024u;
    const int aoff = lds_byte(wr * 64 + fr, fq * 8), boff = lds_byte(wc * 32 + fr, fq * 8);
#define PG8_SA(b, h) (((b) * 2 + (h)) * HTB)
#define PG8_SB(b, h) ((4 + (b) * 2 + (h)) * HTB)
#define PG8_STAGE(bufoff, gbase, voff) do { _Pragma("unroll") for (int _i = 0; _i < 2; ++_i) \
        __builtin_amdgcn_global_load_lds((const unsigned*)((const char*)(gbase) + (voff)[_i]), (LAS unsigned*)(lds + (bufoff) + ldsw + _i * 8192), 16, 0, 0); } while (0)
#define PG8_LDA(dst, b, h) do { _Pragma("unroll") for (int m = 0; m < 4; ++m) _Pragma("unroll") for (int k = 0; k < 2; ++k) dst[m][k] = *(const LAS bf16x8*)(lds + PG8_SA(b, h) + aoff + m * 2048 + k * 1024); } while (0)
#define PG8_LDB(dst, b, h) do { _Pragma("unroll") for (int n = 0; n < 2; ++n) _Pragma("unroll") for (int k = 0; k < 2; ++k) dst[n][k] = *(const LAS bf16x8*)(lds + PG8_SB(b, h) + boff + n * 2048 + k * 1024); } while (0)
#define PG8_MMA(ai, bj, At, Bt) do { __builtin_amdgcn_s_setprio(1); _Pragma("unroll") for (int m = 0; m < 4; ++m) _Pragma("unroll") for (int n = 0; n < 2; ++n) _Pragma("unroll") for (int k = 0; k < 2; ++k) \
        acc[ai][bj][m][n] = __builtin_amdgcn_mfma_f32_16x16x32_bf16(Bt[n][k], At[m][k], acc[ai][bj][m][n], 0, 0, 0); __builtin_amdgcn_s_setprio(0); } while (0)
#define PG8_WAIT_V(n) asm volatile("s_waitcnt vmcnt(" #n ")" ::: "memory")
#define PG8_WAIT_L(n) asm volatile("s_waitcnt lgkmcnt(" #n ")" ::: "memory")
#define PG8_BAR __builtin_amdgcn_s_barrier()
#define PG8_SCHED __builtin_amdgcn_sched_barrier(0)
    Unit cur, nxt; int ui = 0;
    if (!S.next(0, cur)) return;
    float rowf[2][4] = {}; E.prefetch(cur, wr, fr, rowf);
    f32x4 acc[2][2][4][2];
#pragma unroll
    for (int a = 0; a < 2; ++a)
#pragma unroll
        for (int b = 0; b < 2; ++b)
#pragma unroll
            for (int m = 0; m < 4; ++m)
#pragma unroll
                for (int n = 0; n < 2; ++n) acc[a][b][m][n] = (f32x4){0.f, 0.f, 0.f, 0.f};
    bf16x8 At[4][2], B0[2][2], B1[2][2];
    const char* cA = (const char*)g.A + (size_t)cur.pm * tstepA; const char* cB = (const char*)g.Bt + (size_t)cur.pn * tstepB;
    PG8_STAGE(PG8_SB(0, 0), cB, voffB); PG8_STAGE(PG8_SB(0, 1), cB + hstepB, voffB); PG8_STAGE(PG8_SA(0, 0), cA, voffA); PG8_STAGE(PG8_SA(0, 1), cA + hstepA, voffA);
    if (wr == 1) PG8_BAR;
    PG8_WAIT_V(2); PG8_BAR;
    PG8_STAGE(PG8_SB(1, 0), cB + kstep, voffB); PG8_STAGE(PG8_SA(1, 0), cA + kstep, voffA); PG8_STAGE(PG8_SB(1, 1), cB + hstepB + kstep, voffB);
    PG8_WAIT_V(6); PG8_BAR;
    for (;;) {
        const bool has_next = S.next(ui + 1, nxt);
        const char* nA = has_next ? (const char*)g.A + (size_t)nxt.pm * tstepA : cA; const char* nB = has_next ? (const char*)g.Bt + (size_t)nxt.pn * tstepB : cB;
        for (int t = 0; t < nt; t += 2) {
            const bool last = (t == nt - 2);
            const char* a1 = cA + (size_t)(t + 1) * kstep;
            const char* a2 = last ? nA : cA + (size_t)(t + 2) * kstep; const char* b2 = last ? nB : cB + (size_t)(t + 2) * kstep;
            const char* a3 = a2 + kstep; const char* b3 = b2 + kstep;
            PG8_LDB(B0, 0, 0); PG8_LDB(B1, 0, 1); PG8_SCHED; PG8_LDA(At, 0, 0); PG8_STAGE(PG8_SA(1, 1), a1 + hstepA, voffA);
            PG8_WAIT_V(8); PG8_WAIT_L(0); PG8_BAR; PG8_MMA(0, 0, At, B0); PG8_MMA(0, 1, At, B1); PG8_BAR; PG8_SCHED;
            PG8_LDA(At, 0, 1); PG8_STAGE(PG8_SB(0, 0), b2, voffB); PG8_STAGE(PG8_SB(0, 1), b2 + hstepB, voffB); PG8_STAGE(PG8_SA(0, 0), a2, voffA);
            PG8_WAIT_V(8); PG8_WAIT_L(0); PG8_BAR; PG8_MMA(1, 0, At, B0); PG8_MMA(1, 1, At, B1); PG8_BAR; PG8_SCHED;
            PG8_LDB(B0, 1, 0); PG8_LDB(B1, 1, 1); PG8_SCHED; PG8_LDA(At, 1, 0); PG8_STAGE(PG8_SA(0, 1), a2 + hstepA, voffA);
            PG8_WAIT_V(8); PG8_WAIT_L(0); PG8_BAR; PG8_MMA(0, 0, At, B0); PG8_MMA(0, 1, At, B1); PG8_BAR; PG8_SCHED;
            PG8_LDA(At, 1, 1); PG8_STAGE(PG8_SB(1, 0), b3, voffB); PG8_STAGE(PG8_SB(1, 1), b3 + hstepB, voffB); PG8_STAGE(PG8_SA(1, 0), a3, voffA);
            PG8_WAIT_V(8); PG8_WAIT_L(0); PG8_BAR; PG8_MMA(1, 0, At, B0); PG8_MMA(1, 1, At, B1); PG8_BAR; PG8_SCHED;
        }
        if constexpr (ALIGN_EPI) { if (wr == 0) PG8_BAR; }
        if constexpr (Epi::FUSED) E.fused(acc, cur, wr, wc, fr, fq, lds + STAGE_BYTES + 256, tid); else E(acc, cur, wr, wc, fr, fq, rowf);
        if (!has_next) break;
#pragma unroll
        for (int a = 0; a < 2; ++a)
#pragma unroll
            for (int b = 0; b < 2; ++b)
#pragma unroll
                for (int m = 0; m < 4; ++m)
#pragma unroll
                    for (int n = 0; n < 2; ++n) acc[a][b][m][n] = (f32x4){0.f, 0.f, 0.f, 0.f};
        cur = nxt; cA = nA; cB = nB; ++ui; E.prefetch(cur, wr, fr, rowf);
        if constexpr (ALIGN_EPI) { if (wr == 1) PG8_BAR; }
    }
    PG8_WAIT_V(0);
    if constexpr (!ALIGN_EPI) { if (wr == 0) PG8_BAR; }
    PG8_BAR;
#undef PG8_SA
#undef PG8_SB
#undef PG8_STAGE
#undef PG8_LDA
#undef PG8_LDB
#undef PG8_MMA
#undef PG8_WAIT_V
#undef PG8_WAIT_L
#undef PG8_BAR
#undef PG8_SCHED
}
}

namespace att {
#define SBAR() __builtin_amdgcn_sched_barrier(0)
#define SGB(mask, n) __builtin_amdgcn_sched_group_barrier((mask), (n), 0)
constexpr float SCALE = 0.125f;
constexpr float THR = 8.f;
constexpr int SHM_K = 64 * 64 * 2;
#define KSWZ(row, colB) ((row) * 128 + ((colB) ^ ((((row) >> 1) & 7) << 4)))
typedef __bf16 bf16x2_t __attribute__((ext_vector_type(2)));
typedef short v4i16_t __attribute__((ext_vector_type(4)));
typedef LAS const char* lds_cptr;
__device__ __forceinline__ int crow(int r, int hi) { return (r & 3) + 8 * (r >> 2) + 4 * hi; }
__device__ __forceinline__ unsigned cvtpk_s(float lo, float hi) { f32x2 v = {lo, hi}; bf16x2_t b = __builtin_convertvector(v, bf16x2_t); return __builtin_bit_cast(unsigned, b); }
__device__ __forceinline__ s16x4 vtr(lds_cptr p) { return __builtin_bit_cast(s16x4, __builtin_amdgcn_ds_read_tr16_b64_v4i16((LAS v4i16_t*)p)); }

__device__ __forceinline__ void psm_max(const f32x16& p0, const f32x16& p1, float& m_reg, float& alpha, float& mnC) {
    constexpr float C = SCALE * 1.4426950408889634f;
    float pa = fmaxf(fmaxf(p0[0], p0[1]), p1[0]), pb = fmaxf(fmaxf(p0[2], p0[3]), p1[1]); pa = fmaxf(fmaxf(pa, p1[2]), p1[3]);
#pragma unroll
    for (int r = 4; r < 16; r += 4) { pa = fmaxf(fmaxf(pa, p0[r]), p0[r + 1]); pb = fmaxf(fmaxf(pb, p0[r + 2]), p0[r + 3]); pa = fmaxf(fmaxf(pa, p1[r]), p1[r + 1]); pb = fmaxf(fmaxf(pb, p1[r + 2]), p1[r + 3]); }
    float pmax = fmaxf(pa, pb);
    { auto rr = __builtin_amdgcn_permlane32_swap(__float_as_uint(pmax), __float_as_uint(pmax), false, false);
      pmax = fmaxf(__uint_as_float(rr[0]), __uint_as_float(rr[1])); }
    const float mn = (pmax - m_reg > THR / SCALE) ? pmax : m_reg;
    alpha = __builtin_amdgcn_exp2f((m_reg - mn) * C); m_reg = mn;
    mnC = -mn * C;
}
__device__ __forceinline__ void psm_scale(f32x16& p0, f32x16& p1, float mnC) {
    constexpr float C = SCALE * 1.4426950408889634f;
#pragma unroll
    for (int r = 0; r < 16; ++r) p0[r] = fmaf(p0[r], C, mnC);
#pragma unroll
    for (int r = 0; r < 16; ++r) p1[r] = fmaf(p1[r], C, mnC);
}
template <int LO> __device__ __forceinline__ void psm_exp(f32x16& p0) {
#pragma unroll
    for (int r = LO; r < LO + 8; ++r) p0[r] = __builtin_amdgcn_exp2f(p0[r]);
}
__device__ __forceinline__ void partialSM(f32x16& p0, f32x16& p1, float& m_reg, float& alpha) {
    float mnC; psm_max(p0, p1, m_reg, alpha, mnC); psm_scale(p0, p1, mnC); psm_exp<0>(p0); psm_exp<8>(p0);
}
__device__ __forceinline__ void finishSM(f32x16& p0, f32x16& p1, float alpha, float& l_reg, bf16x8& pa0, bf16x8& pa1, bf16x8& pa2, bf16x8& pa3) {
#pragma unroll
    for (int r = 0; r < 16; ++r) p1[r] = __builtin_amdgcn_exp2f(p1[r]);
    float ps0 = 0.f, ps1 = 0.f;
#pragma unroll
    for (int r = 0; r < 16; ++r) { ps0 += p0[r]; ps1 += p1[r]; }
    float ps = ps0 + ps1;
    { auto rr = __builtin_amdgcn_permlane32_swap(__float_as_uint(ps), __float_as_uint(ps), false, false);
      ps = __uint_as_float(rr[0]) + __uint_as_float(rr[1]); }
    l_reg = l_reg * alpha + ps;
#define PK4(P, BASE, OUT) do { unsigned a0 = cvtpk_s(P[BASE + 0], P[BASE + 1]), a1 = cvtpk_s(P[BASE + 2], P[BASE + 3]);   \
    unsigned b0 = cvtpk_s(P[BASE + 4], P[BASE + 5]), b1 = cvtpk_s(P[BASE + 6], P[BASE + 7]);                              \
    auto r0 = __builtin_amdgcn_permlane32_swap(a0, b0, false, false); auto r1 = __builtin_amdgcn_permlane32_swap(a1, b1, false, false); \
    u32x4 w = {r0[0], r1[0], r0[1], r1[1]}; OUT = __builtin_bit_cast(bf16x8, w); } while (0)
    PK4(p0, 0, pa0); PK4(p0, 8, pa1); PK4(p1, 0, pa2); PK4(p1, 8, pa3);
#undef PK4
}
__device__ __forceinline__ void qkt(f32x16& p0, f32x16& p1, lds_cptr Ks, const bf16x8* qr, int r32, int hi) {
    p0 = f32x16{}; p1 = f32x16{};
    bf16x8 b0[4], b1[4];
#pragma unroll
    for (int d0 = 0; d0 < 4; ++d0) { const int cb = (d0 * 16 + hi * 8) * 2;
        b0[d0] = *reinterpret_cast<const LAS bf16x8*>(Ks + KSWZ(r32, cb));
        b1[d0] = *reinterpret_cast<const LAS bf16x8*>(Ks + KSWZ(32 + r32, cb)); }
#pragma unroll
    for (int d0 = 0; d0 < 4; ++d0) {
        p0 = __builtin_amdgcn_mfma_f32_32x32x16_bf16(b0[d0], qr[d0], p0, 0, 0, 0);
        p1 = __builtin_amdgcn_mfma_f32_32x32x16_bf16(b1[d0], qr[d0], p1, 0, 0, 0); }
}
template <int DV> __device__ __forceinline__ int v_st(int k, int c) { const int kk = (k & ~0xC) | ((k & 4) << 1) | ((k & 8) >> 1); return ((kk >> 3) * (DV / 32) + (c >> 5)) * 512 + ((kk & 7) * 32 + (c & 31)) * 2; }
__device__ __forceinline__ int v_rd_base(int lane) { return ((lane & 3) << 3) | (((lane >> 2) & 3) << 6) | (((lane >> 4) & 1) << 5) | (((lane >> 5) & 1) << 8); }
template <int DV> struct VFrag { s16x4 l[DV / 32], h[DV / 32]; };
template <int DV, int KS_IDX> __device__ __forceinline__ void v_rd(VFrag<DV>& f, lds_cptr vb) {
    constexpr int KS = DV * 32, HF = DV * 16;
#pragma unroll
    for (int d = 0; d < DV / 32; ++d) { f.l[d] = vtr(vb + d * 512 + KS_IDX * KS); f.h[d] = vtr(vb + d * 512 + KS_IDX * KS + HF); }
}
template <int DV> __device__ __forceinline__ void v_mma(f32x16* o, const VFrag<DV>& f, bf16x8 pa) {
#pragma unroll
    for (int d = 0; d < DV / 32; ++d) o[d] = __builtin_amdgcn_mfma_f32_32x32x16_bf16(pa, (bf16x8){f.l[d][0], f.l[d][1], f.l[d][2], f.l[d][3], f.h[d][0], f.h[d][1], f.h[d][2], f.h[d][3]}, o[d], 0, 0, 0);
}
template <int DV> __device__ __forceinline__ void pv_all(f32x16* o, lds_cptr vb, bf16x8 pa0, bf16x8 pa1, bf16x8 pa2, bf16x8 pa3) {
    VFrag<DV> A, B;
    v_rd<DV, 0>(A, vb); v_rd<DV, 1>(B, vb); v_mma<DV>(o, A, pa0);
    v_rd<DV, 2>(A, vb); v_mma<DV>(o, B, pa1);
    v_rd<DV, 3>(B, vb); v_mma<DV>(o, A, pa2);
    v_mma<DV>(o, B, pa3);
}
template <int DV> __device__ __forceinline__ void pv_psm(f32x16* o, lds_cptr vb, bf16x8 pa0, bf16x8 pa1, bf16x8 pa2, bf16x8 pa3, f32x16& p0, f32x16& p1, float& m_reg, float& alpha) {
    constexpr int ND = DV / 32, NV = (DV == 128) ? 8 : 16;
    VFrag<DV> A, B; float mnC;
    v_rd<DV, 0>(A, vb); SBAR();
    v_rd<DV, 1>(B, vb); v_mma<DV>(o, A, pa0); psm_max(p0, p1, m_reg, alpha, mnC);
    SGB(0x100, 2 * ND);
#pragma unroll
    for (int i = 0; i < ND; ++i) { SGB(0x008, 1); SGB(0x002, NV); }
    SBAR();
    v_rd<DV, 2>(A, vb); v_mma<DV>(o, B, pa1); psm_scale(p0, p1, mnC);
    SGB(0x100, 2 * ND);
#pragma unroll
    for (int i = 0; i < ND; ++i) { SGB(0x008, 1); SGB(0x002, NV); }
    SBAR();
    v_rd<DV, 3>(B, vb); v_mma<DV>(o, A, pa2); psm_exp<0>(p0);
    SGB(0x100, 2 * ND);
#pragma unroll
    for (int i = 0; i < ND; ++i) { SGB(0x008, 1); SGB(0x400, 8 / ND); }
    SBAR();
    v_mma<DV>(o, B, pa3); psm_exp<8>(p0);
#pragma unroll
    for (int i = 0; i < ND; ++i) { SGB(0x008, 1); SGB(0x400, 8 / ND); }
    asm volatile("" : "+v"(p0), "+v"(p1));
    SBAR();
}

template <int DV, int ldq, int ldk, int ldv>
__device__ __forceinline__ void attn_pass(const bf16_t* __restrict__ Qw, const bf16_t* __restrict__ Kh, const bf16_t* __restrict__ Vh,
                                          int NT, char* lds, f32x16 (&o)[DV / 32], float& l_out) {
    constexpr int ND = DV / 32, SHM_V = 64 * DV * 2, NVP = DV / 64;
    int tid = threadIdx.x; asm volatile("" : "+v"(tid));
    const int wid = __builtin_amdgcn_readfirstlane(tid >> 6), lane = tid & 63, r32 = lane & 31, hi = lane >> 5;
    const lds_cptr lds3 = (lds_cptr)lds;
    const lds_cptr V3 = lds3, K3 = lds3 + 4 * SHM_V;
    LAS float* al_l = (LAS float*)(lds3 + 4 * SHM_V + 4 * SHM_K) + wid * 64 + 32;
    LAS unsigned char* Vw = (LAS unsigned char*)lds3; LAS unsigned char* Kw = (LAS unsigned char*)lds3 + 4 * SHM_V;
    float m_reg = -1e30f, l_reg = 0; bf16x8 qr[4];
#pragma unroll
    for (int d = 0; d < ND; ++d) o[d] = f32x16{};
    const bf16_t* Ql = Qw + r32 * ldq + hi * 8;
#pragma unroll
    for (int d0 = 0; d0 < 4; ++d0) qr[d0] = *reinterpret_cast<const bf16x8*>(Ql + d0 * 16);
    const int krow = 8 * wid + (lane >> 3), kch = (lane & 7) ^ ((krow >> 1) & 7);
    const bf16_t* ksrc = Kh + krow * ldk + kch * 8;
    const bf16_t* vsrc[NVP];
#pragma unroll
    for (int i = 0; i < NVP; ++i) { const int p = (NVP * wid + i) * 64 + lane, st = p >> 5, kk = (st / (DV / 32)) * 8 + ((p >> 2) & 7);
        const int k = (kk & ~0xC) | ((kk & 4) << 1) | ((kk & 8) >> 1), c = (st % (DV / 32)) * 32 + (p & 3) * 8; vsrc[i] = Vh + k * ldv + c; }
    const lds_cptr vb0 = V3 + v_rd_base(lane);
#define DMA(t, slot) do { __builtin_amdgcn_global_load_lds((const unsigned*)(ksrc + (size_t)(t) * 64 * ldk), (LAS unsigned*)(Kw + (slot) * SHM_K + wid * 1024), 16, 0, 0); \
    _Pragma("unroll") for (int _i = 0; _i < NVP; ++_i) __builtin_amdgcn_global_load_lds((const unsigned*)(vsrc[_i] + (size_t)(t) * 64 * ldv), (LAS unsigned*)(Vw + (slot) * SHM_V + (NVP * wid + _i) * 1024), 16, 0, 0); } while (0)
#define RESC(a) do { if (__any((a) < 1.f)) { if (hi == 0) al_l[r32] = (a); \
    _Pragma("unroll") for (int d = 0; d < ND; ++d) _Pragma("unroll") for (int r = 0; r < 16; ++r) o[d][r] *= al_l[crow(r, hi)]; } } while (0)
#define HINT_R1() do { SGB(0x100, 8); _Pragma("unroll") for (int _i = 0; _i < 8; ++_i) { SGB(0x008, 1); SGB(0x400, 2); SGB(0x002, 10); } } while (0)
#define DRAIN_BAR() do { asm volatile("s_waitcnt vmcnt(0) lgkmcnt(0)\n\ts_barrier" ::: "memory"); } while (0)
#define COUNT_BAR() do { if constexpr (DV == 128) asm volatile("s_waitcnt vmcnt(3) lgkmcnt(0)\n\ts_barrier" ::: "memory"); else asm volatile("s_waitcnt vmcnt(2) lgkmcnt(0)\n\ts_barrier" ::: "memory"); } while (0)
    f32x16 pA0, pA1, pB0, pB1; float alA, alB; bf16x8 pa0, pa1, pa2, pa3;
    DMA(0, 0); DMA(1, 1); DMA(2, 2); DRAIN_BAR();
    qkt(pA0, pA1, K3, qr, r32, hi); partialSM(pA0, pA1, m_reg, alA);
#define BODY(Pc0, Pc1, alc, Pn0, Pn1, aln, j) do { \
        const bool more_ = ((j) + 3 < NT); \
        if (more_) DMA((j) + 3, ((j) + 3) & 3); \
        SBAR(); qkt(Pn0, Pn1, K3 + (((j) + 1) & 3) * SHM_K, qr, r32, hi); \
        finishSM(Pc0, Pc1, alc, l_reg, pa0, pa1, pa2, pa3); HINT_R1(); SBAR(); \
        pv_psm<DV>(o, vb0 + ((j) & 3) * SHM_V, pa0, pa1, pa2, pa3, Pn0, Pn1, m_reg, aln); \
        RESC(aln); if (more_) COUNT_BAR(); else DRAIN_BAR(); } while (0)
    for (int j = 0; j + 2 < NT; j += 2) {
        BODY(pA0, pA1, alA, pB0, pB1, alB, j);
        BODY(pB0, pB1, alB, pA0, pA1, alA, j + 1);
    }
    BODY(pA0, pA1, alA, pB0, pB1, alB, NT - 2);
    finishSM(pB0, pB1, alB, l_reg, pa0, pa1, pa2, pa3); SBAR();
    pv_all<DV>(o, vb0 + ((NT - 1) & 3) * SHM_V, pa0, pa1, pa2, pa3);
    l_out = l_reg;
    __syncthreads();
#undef DMA
#undef RESC
#undef HINT_R1
#undef DRAIN_BAR
#undef COUNT_BAR
#undef BODY
}
template <int DV> __device__ __forceinline__ void row_rcp(char* lds, float l_reg, float (&rli)[16]) {
    int tid = threadIdx.x; asm volatile("" : "+v"(tid));
    const int wid = tid >> 6, lane = tid & 63, r32 = lane & 31, hi = lane >> 5;
    LAS float* li_l = (LAS float*)((lds_cptr)lds + 4 * (64 * DV * 2) + 4 * SHM_K) + wid * 64;
    if (hi == 0) li_l[r32] = l_reg;
#pragma unroll
    for (int r = 0; r < 16; ++r) rli[r] = __builtin_amdgcn_rcpf(li_l[crow(r, hi)]);
}
}

struct Args { const void* in[29]; float* out; unsigned char* ws; };

struct Ctx {
    int wave, vcu, G, gw, NGW;
    unsigned char* ws;
};
__device__ __forceinline__ int opaque_tid() { int t = threadIdx.x; asm volatile("" : "+v"(t)); return t; }

__device__ __forceinline__ void transpose_item(const float* W, int N, bf16_t* WT, int ldt, int coff, int mode, LAS float* scr, int item, int lane, const float* gk = nullptr) {
    const int nblk = N / 32, kb = item / nblk, nb = item % nblk, k0 = 64 * kb, n0 = 32 * nb;
    float wv[32];
#pragma unroll
    for (int i = 0; i < 32; ++i) { const int kk = 2 * i + (lane >> 5); wv[i] = __builtin_nontemporal_load(W + (size_t)(k0 + kk) * N + n0 + (lane & 31)); }
    if (gk) {
#pragma unroll
        for (int i = 0; i < 32; ++i) wv[i] *= gk[k0 + 2 * i + (lane >> 5)]; }
#pragma unroll
    for (int i = 0; i < 32; ++i) { const int kk = 2 * i + (lane >> 5); scr[kk * 33 + (lane & 31)] = wv[i]; }
    asm volatile("s_waitcnt lgkmcnt(0)" ::: "memory");
    int d0 = n0;
    if (mode == 1) d0 = (n0 < FF) ? ((n0 >> 7) * 256 + (n0 & 127)) : (((n0 - FF) >> 7) * 256 + 128 + ((n0 - FF) & 127));
    const int c = lane & 7;
#pragma unroll
    for (int j = 0; j < 4; ++j) { const int n = (lane >> 3) + 8 * j; const LAS float* s = scr + (8 * c) * 33 + n;
        u32x4 o; o.x = cvt_pk_bf16(s[0 * 33], s[1 * 33]); o.y = cvt_pk_bf16(s[2 * 33], s[3 * 33]); o.z = cvt_pk_bf16(s[4 * 33], s[5 * 33]); o.w = cvt_pk_bf16(s[6 * 33], s[7 * 33]);
        *(u32x4*)(WT + (size_t)(d0 + n) * ldt + coff + k0 + 8 * c) = o; }
    asm volatile("s_waitcnt lgkmcnt(0)" ::: "memory");
}

__device__ __forceinline__ void convert_layer(const Ctx& C, const Args& A, LAS unsigned char* lds, int l) {
    const int lane = opaque_tid() & 63;
    LAS float* scr = (LAS float*)(lds + C.wave * 16384);
    unsigned char* wb = C.ws + WS_W;
    const float* up1 = (const float*)A.in[4] + (size_t)l * DM * NUP;  const float* dn1 = (const float*)A.in[5] + (size_t)l * FF * DM;
    const float* win = (const float*)A.in[8] + (size_t)l * DM * INW;  const float* wg = (const float*)A.in[18] + (size_t)l * DM * 3072;
    const float* brp = (const float*)A.in[20] + (size_t)l * 256 * DM; const float* brd = (const float*)A.in[21] + (size_t)l * 512 * DM;
    const float* brc = (const float*)A.in[22] + (size_t)l * 256 * DM; const float* wo = (const float*)A.in[23] + (size_t)l * DM * DM;
    const float* up2 = (const float*)A.in[26] + (size_t)l * DM * NUP; const float* dn2 = (const float*)A.in[27] + (size_t)l * FF * DM;
    const float* g_f1 = (const float*)A.in[3] + (size_t)l * DM; const float* g_mx = (const float*)A.in[7] + (size_t)l * DM; const float* g_f2 = (const float*)A.in[25] + (size_t)l * DM;
    const float* wkv = (const float*)A.in[17] + (size_t)l * DM * 512; const float* pw = (const float*)A.in[9] + (size_t)l * 4 * 64 * 64;
    constexpr int I_UP = (DM / 64) * (NUP / 32), I_DN = (FF / 64) * (DM / 32), I_IN = (DM / 64) * (INW / 32), I_G = (DM / 64) * (3072 / 32),
                  I_BP = (256 / 64) * (DM / 32), I_BD = (512 / 64) * (DM / 32), I_O = (DM / 64) * (DM / 32), I_KV = (DM / 64) * (512 / 32), I_PW = 2;
    constexpr int NITEMS = 2 * I_UP + 2 * I_DN + I_IN + I_G + 2 * I_BP + I_BD + I_O + I_KV + 4 * I_PW;
    for (int it = C.gw; it < NITEMS; it += C.NGW) {
        int r = it;
#define TR(Wp, Kk, Nn, WTo, ldt, coff, mode, NI) if (r < (NI)) { transpose_item((Wp), (Nn), (bf16_t*)(wb + (WTo)), (ldt), (coff), (mode), scr, r, lane); continue; } r -= (NI);
#define TRG(Wp, Kk, Nn, WTo, ldt, coff, mode, NI, G) if (r < (NI)) { transpose_item((Wp), (Nn), (bf16_t*)(wb + (WTo)), (ldt), (coff), (mode), scr, r, lane, (G)); continue; } r -= (NI);
        TRG(up1, DM, NUP, W_UP1, DM, 0, 1, I_UP, g_f1)
        TRG(up2, DM, NUP, W_UP2, DM, 0, 1, I_UP, g_f2)
        TR(dn1, FF, DM, W_DN1, FF, 0, 0, I_DN)
        TR(dn2, FF, DM, W_DN2, FF, 0, 0, I_DN)
        TRG(win, DM, INW, W_IN, DM, 0, 0, I_IN, g_mx)
        TRG(wg, DM, 3072, W_GATE, DM, 0, 0, I_G, g_mx)
        TR(brp, 256, DM, W_BRP, 256, 0, 0, I_BP)
        TR(brd, 512, DM, W_BRD, 512, 0, 0, I_BD)
        TR(brc, 256, DM, W_BRC, 256, 0, 0, I_BP)
        TR(wo, DM, DM, W_OUT3, DM, 0, 0, I_O)
        TR(wkv, DM, 512, W_KV, DM, 0, 0, I_KV)
        TR(pw, 64, 64, W_POOL, 64, 0, 0, I_PW)
        TR(pw + 4096, 64, 64, W_POOL + 8192, 64, 0, 0, I_PW)
        TR(pw + 8192, 64, 64, W_POOL + 16384, 64, 0, 0, I_PW)
        TR(pw + 12288, 64, 64, W_POOL + 24576, 64, 0, 0, I_PW)
#undef TR
#undef TRG
    }
    const float* mem = (const float*)A.in[1]; const float* mg = (const float*)A.in[16] + (size_t)l * DM; bf16_t* memn = (bf16_t*)(C.ws + WS_MEMN);
    for (int row = C.gw; row < NBATCH * NMEM; row += C.NGW) {
        const f32x4* xr = (const f32x4*)(mem + (size_t)row * DM) + lane; f32x4 v[4]; float ss = 0.f;
#pragma unroll
        for (int j = 0; j < 4; ++j) { v[j] = xr[64 * j]; ss += (v[j].x * v[j].x + v[j].y * v[j].y) + (v[j].z * v[j].z + v[j].w * v[j].w); }
        const float rs = 1.0f / sqrtf(wave_sum(ss) * (1.f / DM) + NORM_EPS);
#pragma unroll
        for (int j = 0; j < 4; ++j) { const f32x4 gg = *((const f32x4*)mg + lane + 64 * j); const f32x4 t = v[j] * rs * gg;
            u32x2 w; w.x = cvt_pk_bf16(t.x, t.y); w.y = cvt_pk_bf16(t.z, t.w); *((u32x2*)(memn + (size_t)row * DM) + lane + 64 * j) = w; }
    }
}

__device__ __forceinline__ void norm_phase(const Ctx& C, const float* Xf, bf16_t* XB, const bf16_t* T1, const float* gpost, float scale, float* rstd, float* Fout, bf16_t* XBo = nullptr) {
    if (XBo == nullptr) XBo = XB;
    const int lane = opaque_tid() & 63;
    for (int row0 = C.gw; row0 < NTOK; row0 += 2 * C.NGW) {
        f32x4 v[2][4]; u32x2 tw[2][4];
#pragma unroll
        for (int q = 0; q < 2; ++q) { const int row = row0 + q * C.NGW;
            if (Xf) {
#pragma unroll
                for (int j = 0; j < 4; ++j) v[q][j] = __builtin_nontemporal_load((const f32x4*)(Xf + (size_t)row * DM) + lane + 64 * j);
            } else {
#pragma unroll
                for (int j = 0; j < 4; ++j) { const u32x2 w = *((const u32x2*)(XB + (size_t)row * DM) + lane + 64 * j); v[q][j] = (f32x4){bf_lo(w.x), bf_hi(w.x), bf_lo(w.y), bf_hi(w.y)}; }
            }
            if (T1) {
#pragma unroll
                for (int j = 0; j < 4; ++j) tw[q][j] = __builtin_nontemporal_load((const u32x2*)(T1 + (size_t)row * DM) + lane + 64 * j);
            } }
#pragma unroll
        for (int q = 0; q < 2; ++q) { const int row = row0 + q * C.NGW;
            if (T1) {
                f32x4 t[4]; float ss = 0.f;
#pragma unroll
                for (int j = 0; j < 4; ++j) { const u32x2 w = tw[q][j];
                    t[j] = (f32x4){bf_lo(w.x), bf_hi(w.x), bf_lo(w.y), bf_hi(w.y)}; ss += (t[j].x * t[j].x + t[j].y * t[j].y) + (t[j].z * t[j].z + t[j].w * t[j].w); }
                const float rs = scale / sqrtf(wave_sum(ss) * (1.f / DM) + NORM_EPS);
#pragma unroll
                for (int j = 0; j < 4; ++j) { const f32x4 gg = *((const f32x4*)gpost + lane + 64 * j); v[q][j] = v[q][j] + t[j] * rs * gg; }
            }
            if (Fout) {
#pragma unroll
                for (int j = 0; j < 4; ++j) __builtin_nontemporal_store(v[q][j], (f32x4*)(Fout + (size_t)row * DM) + lane + 64 * j);
            } else {
                float ss = 0.f;
#pragma unroll
                for (int j = 0; j < 4; ++j) { ss += (v[q][j].x * v[q][j].x + v[q][j].y * v[q][j].y) + (v[q][j].z * v[q][j].z + v[q][j].w * v[q][j].w);
                    u32x2 w; w.x = cvt_pk_bf16(v[q][j].x, v[q][j].y); w.y = cvt_pk_bf16(v[q][j].z, v[q][j].w); *((u32x2*)(XBo + (size_t)row * DM) + lane + 64 * j) = w; }
                const float st = wave_sum(ss);
                if (lane == 0) *(f32x4*)(rstd + (size_t)row * 4) = (f32x4){st, 0.f, 0.f, 0.f};
            }
        }
    }
}

__device__ __forceinline__ void rope_table(const Ctx& C, const Args& A) {
    const int* pos = (const int*)A.in[2]; float* tab = (float*)(C.ws + WS_ROPE);
    const int tid = opaque_tid();
    for (int idx = blockIdx.x * NTHR + tid; idx < NTOK * 8; idx += C.G * NTHR) {
        const int row = idx >> 3, i = idx & 7;
        const double inv = (i == 0) ? 1.0 : (i == 1) ? 0.19392274474868576 : (i == 2) ? 0.03760603093086393 : (i == 3) ? 0.007292664737217109 :
                           (i == 4) ? 0.001414213562373095 : (i == 5) ? 0.0002742481756762073 : (i == 6) ? 5.318295896944988e-05 : 1.031338537721246e-05;
        const double rev = (double)pos[row] * inv * 0.15915494309189535;
        const float fr = (float)(rev - __builtin_rint(rev));
        tab[(size_t)row * 16 + i] = __builtin_amdgcn_cosf(fr); tab[(size_t)row * 16 + 8 + i] = __builtin_amdgcn_sinf(fr);
    }
}

template <int G>
__device__ __forceinline__ void pool_item(const bf16_t* INP, bf16_t* Y, const bf16_t* PWT, const float* pscale, int rb, int r32, int hi) {
    constexpr int W2 = 1 << G;
    const int row = rb * 32 + r32, s = row & (SEQ - 1), b0 = row - s;
    const int lo = (s - W2 < 0) ? 0 : s - W2, hi_ = (s + W2 > SEQ) ? SEQ : s + W2;
    const float rc = 1.0f / (float)(hi_ - lo);
    f32x16 a0 = f32x16{}, a1 = f32x16{};
#pragma unroll
    for (int ks = 0; ks < 4; ++ks) {
        const int ch = G * 64 + ks * 16 + hi * 8;
        u32x4 w[2 * W2];
#pragma unroll
        for (int jj = 0; jj < 2 * W2; ++jj) { int j = s - W2 + jj; j = j < 0 ? 0 : (j > SEQ - 1 ? SEQ - 1 : j); w[jj] = *(const u32x4*)(INP + (size_t)(b0 + j) * INW + ch); }
        float sum[8];
#pragma unroll
        for (int e = 0; e < 8; ++e) sum[e] = 0.f;
#pragma unroll
        for (int jj = 0; jj < 2 * W2; ++jj) { const int j = s - W2 + jj; const float m = (j >= 0 && j < SEQ) ? 1.f : 0.f;
            sum[0] += m * bf_lo(w[jj].x); sum[1] += m * bf_hi(w[jj].x); sum[2] += m * bf_lo(w[jj].y); sum[3] += m * bf_hi(w[jj].y);
            sum[4] += m * bf_lo(w[jj].z); sum[5] += m * bf_hi(w[jj].z); sum[6] += m * bf_lo(w[jj].w); sum[7] += m * bf_hi(w[jj].w); }
        const u32x4 uw = w[W2];
        const float u[8] = {bf_lo(uw.x), bf_hi(uw.x), bf_lo(uw.y), bf_hi(uw.y), bf_lo(uw.z), bf_hi(uw.z), bf_lo(uw.w), bf_hi(uw.w)};
        u32x4 pa; pa.x = cvt_pk_bf16(sum[0] * rc - u[0], sum[1] * rc - u[1]); pa.y = cvt_pk_bf16(sum[2] * rc - u[2], sum[3] * rc - u[3]);
        pa.z = cvt_pk_bf16(sum[4] * rc - u[4], sum[5] * rc - u[5]); pa.w = cvt_pk_bf16(sum[6] * rc - u[6], sum[7] * rc - u[7]);
        const bf16x8 af = *reinterpret_cast<bf16x8*>(&pa);
        const bf16x8 w0 = *reinterpret_cast<const bf16x8*>(PWT + (size_t)G * 4096 + (size_t)r32 * 64 + ks * 16 + hi * 8);
        const bf16x8 w1 = *reinterpret_cast<const bf16x8*>(PWT + (size_t)G * 4096 + (size_t)(32 + r32) * 64 + ks * 16 + hi * 8);
        a0 = __builtin_amdgcn_mfma_f32_32x32x16_bf16(af, w0, a0, 0, 0, 0);
        a1 = __builtin_amdgcn_mfma_f32_32x32x16_bf16(af, w1, a1, 0, 0, 0);
    }
    const float sc0 = pscale[G * 64 + r32], sc1 = pscale[G * 64 + 32 + r32];
#pragma unroll
    for (int r = 0; r < 16; ++r) { bf16_t* yp = Y + (size_t)(rb * 32 + att::crow(r, hi)) * DM + G * 64 + r32;
        yp[0] = (bf16_t)(cvt_pk_bf16(a0[r] * sc0, 0.f) & 0xffffu); yp[32] = (bf16_t)(cvt_pk_bf16(a1[r] * sc1, 0.f) & 0xffffu); }
}
__device__ __forceinline__ void pool_phase(const Ctx& C, const Args& A, int l) {
    const bf16_t* INP = (const bf16_t*)(C.ws + WS_BIG); bf16_t* Y = (bf16_t*)(C.ws + WS_Y);
    const bf16_t* PWT = (const bf16_t*)(C.ws + WS_W + W_POOL);
    const float* pscale = (const float*)A.in[10] + (size_t)l * 256;
    const int lane = opaque_tid() & 63, r32 = lane & 31, hi = lane >> 5;
    for (int it = C.gw, k = 0; it < (NTOK / 32) * 4; it += C.NGW, ++k) {
        const int rb = it >> 2, g = (it + k) & 3;
        if (g == 0) pool_item<0>(INP, Y, PWT, pscale, rb, r32, hi);
        else if (g == 1) pool_item<1>(INP, Y, PWT, pscale, rb, r32, hi);
        else if (g == 2) pool_item<2>(INP, Y, PWT, pscale, rb, r32, hi);
        else pool_item<3>(INP, Y, PWT, pscale, rb, r32, hi);
    }
}

__device__ __forceinline__ void da_unit(const Ctx& C, const Args& A, char* lds, int l, int b, int h, int qb, float lam) {
    const bf16_t* INP = (const bf16_t*)(C.ws + WS_BIG); bf16_t* Y = (bf16_t*)(C.ws + WS_Y); float* OT = (float*)(C.ws + WS_OT);
    const size_t rowb = (size_t)b * SEQ;
#pragma unroll 1
    for (int c = 0; c < 2; ++c) {
        f32x16 o[4]; float l_reg; float rli[16];
        {
            const int wid0 = __builtin_amdgcn_readfirstlane(threadIdx.x >> 6);
            const size_t row0 = rowb + (size_t)qb * 256 + wid0 * 32;
            const bf16_t* Vh = INP + rowb * INW + 1280 + h * 128;
            const bf16_t* Qw = INP + row0 * INW + 256 + (h * 2 + c) * 64; const bf16_t* Kh = INP + rowb * INW + 768 + (h * 2 + c) * 64;
            att::attn_pass<128, INW, INW, INW>(Qw, Kh, Vh, SEQ / 64, lds, o, l_reg);
        }
        att::row_rcp<128>(lds, l_reg, rli);
        int tid = threadIdx.x; asm volatile("" : "+v"(tid));
        const int wid = tid >> 6, lane = tid & 63, r32 = lane & 31, hi = lane >> 5;
        const size_t row0 = rowb + (size_t)qb * 256 + wid * 32;
        float* OTw = OT + (row0 + 4 * hi) * 512 + h * 128 + r32;
        if (c == 0) {
#pragma unroll
            for (int r = 0; r < 16; ++r) {
#pragma unroll
                for (int d0 = 0; d0 < 4; ++d0) OTw[((r & 3) + 8 * (r >> 2)) * 512 + d0 * 32] = o[d0][r] * rli[r]; }
        } else {
            const float* sg = (const float*)A.in[15] + (size_t)l * 128;
            const float lam_init = 0.8f - 0.6f * expf(-0.3f * (float)l);
            float gcol[4];
#pragma unroll
            for (int d0 = 0; d0 < 4; ++d0) gcol[d0] = sg[d0 * 32 + r32] * (1.0f - lam_init);
            bf16_t* Yw = Y + (row0 + 4 * hi) * DM + 256 + h * 128 + r32;
#pragma unroll
            for (int r = 0; r < 16; ++r) { float ss = 0.f; float v[4];
#pragma unroll
                for (int d0 = 0; d0 < 4; ++d0) { v[d0] = OTw[((r & 3) + 8 * (r >> 2)) * 512 + d0 * 32] - lam * (o[d0][r] * rli[r]); ss += v[d0] * v[d0]; }
#pragma unroll
                for (int off = 1; off < 32; off <<= 1) ss += __shfl_xor(ss, off);
                const float rs = 1.0f / sqrtf(ss * (1.f / 128.f) + NORM_EPS);
#pragma unroll
                for (int d0 = 0; d0 < 4; ++d0) Yw[((r & 3) + 8 * (r >> 2)) * DM + d0 * 32] = (bf16_t)(cvt_pk_bf16(v[d0] * rs * gcol[d0], 0.f) & 0xffffu);
                asm volatile("" ::: "memory"); }
        }
    }
}
__device__ __forceinline__ void ca_unit(const Ctx& C, char* lds, int b, int h, int qb) {
    const bf16_t* INP = (const bf16_t*)(C.ws + WS_BIG); bf16_t* Y = (bf16_t*)(C.ws + WS_Y); const bf16_t* KVM = (const bf16_t*)(C.ws + WS_KVM);
    const int tid = opaque_tid(), wid = tid >> 6, lane = tid & 63, r32 = lane & 31, hi = lane >> 5;
    const size_t row0 = (size_t)b * SEQ + (size_t)qb * 256 + wid * 32;
    const bf16_t* Qw = INP + row0 * INW + 1792 + h * 64;
    const bf16_t* Kh = KVM + (size_t)b * NMEM * 512 + h * 64; const bf16_t* Vh = Kh + 256;
    f32x16 o[2]; float l_reg; float rli[16];
    att::attn_pass<64, INW, 512, 512>(Qw, Kh, Vh, NMEM / 64, lds, o, l_reg);
    att::row_rcp<64>(lds, l_reg, rli);
#pragma unroll
    for (int r = 0; r < 16; ++r) { bf16_t* yp = Y + (row0 + att::crow(r, hi)) * DM + 768 + h * 64 + r32;
#pragma unroll
        for (int d0 = 0; d0 < 2; ++d0) yp[d0 * 32] = (bf16_t)(cvt_pk_bf16(o[d0][r] * rli[r], 0.f) & 0xffffu); }
}


#define XB_TMO      128
#define XB_XCNT(j)  (256  + 64 * (j))
#define XB_XSUB(j)  (1280 + 64 * (j))
#define XB_XGEN(j)  (2304 + 64 * (j))
#define XB_TOP      3328
#define XB_TOPGEN   3392
#define XCD_BAR_WORDS 3456
#define XB_SPIN_CAP (1u << 20)
__device__ __forceinline__ unsigned xb_ld(unsigned* p)              { return __hip_atomic_load(p, __ATOMIC_RELAXED, __HIP_MEMORY_SCOPE_AGENT); }
__device__ __forceinline__ unsigned xb_add(unsigned* p, unsigned v) { return __hip_atomic_fetch_add(p, v, __ATOMIC_RELAXED, __HIP_MEMORY_SCOPE_AGENT); }
__device__ __forceinline__ unsigned xb_xcc_id() { return (unsigned)__builtin_amdgcn_s_getreg((3 << 11) | 20) & 0xFu; }
#define XB_SPIN(cond, bar) do { unsigned _sp = 0; while (cond) { __builtin_amdgcn_s_sleep(1); \
    if ((++_sp & 255u) == 0u) { if (xb_ld(&(bar)[XB_TMO])) break; if (_sp > XB_SPIN_CAP) { atomicAdd(&(bar)[XB_TMO], 1u); break; } } } } while (0)
struct XcdBarrier { unsigned* bar; unsigned x; volatile LAS unsigned* st; };
__device__ __forceinline__ XcdBarrier xcd_barrier_post(unsigned* bar, volatile LAS unsigned* st) {
    XcdBarrier b; b.bar = bar; b.x = xb_xcc_id(); b.st = st;
    if (threadIdx.x == 0) (void)xb_add(&bar[XB_XCNT(b.x)], 1u);
    return b;
}
__device__ __forceinline__ void xcd_barrier_complete(unsigned* bar, unsigned x, unsigned& nloc, unsigned& nx) {
    const unsigned G = gridDim.x * gridDim.y * gridDim.z;
    unsigned sum, cnt, mine, sp = 0u;
    for (;;) {
        sum = 0u; cnt = 0u; mine = 0u;
#pragma unroll
        for (unsigned j = 0; j < 16; ++j) { const unsigned c = xb_ld(&bar[XB_XCNT(j)]); sum += c; cnt += (c > 0u) ? 1u : 0u; mine = (j == x) ? c : mine; }
        if (sum == G) break;
        __builtin_amdgcn_s_sleep(1);
        if ((++sp & 255u) == 0u) { if (xb_ld(&bar[XB_TMO])) break; if (sp > XB_SPIN_CAP) { atomicAdd(&bar[XB_TMO], 1u); break; } }
    }
    nloc = mine > 0u ? mine : 1u; nx = cnt > 0u ? cnt : 1u;
}
__device__ __forceinline__ void xcd_barrier(const XcdBarrier& b) {
    asm volatile("s_waitcnt vmcnt(0)" ::: "memory");
    __syncthreads();
    if (threadIdx.x == 0) {
        unsigned* bar = b.bar;
        __builtin_amdgcn_s_waitcnt(0);
        unsigned nloc = b.st[0], nx = b.st[1];
        if (nloc == 0u) { xcd_barrier_complete(bar, b.x, nloc, nx); b.st[0] = nloc; b.st[1] = nx; }
        const unsigned old = xb_add(&bar[XB_XSUB(b.x)], 1u);
        const unsigned gen = old / nloc;
        if (old + 1u == (gen + 1u) * nloc) {
            __builtin_amdgcn_fence(__ATOMIC_RELEASE, "agent");
            asm volatile("s_waitcnt vmcnt(0)" ::: "memory");
            const unsigned og = xb_add(&bar[XB_TOP], 1u);
            const unsigned tg = og / nx;
            if (og + 1u == (tg + 1u) * nx) xb_add(&bar[XB_TOPGEN], 1u);
            else XB_SPIN(xb_ld(&bar[XB_TOPGEN]) == tg, bar);
            __builtin_amdgcn_fence(__ATOMIC_ACQUIRE, "agent");
            xb_add(&bar[XB_XGEN(b.x)], 1u);
            asm volatile("s_waitcnt vmcnt(0)" ::: "memory");
        } else {
            XB_SPIN(xb_ld(&bar[XB_XGEN(b.x)]) == gen, bar);
            __builtin_amdgcn_fence(__ATOMIC_ACQUIRE, "agent");
            asm volatile("s_waitcnt vmcnt(0)" ::: "memory");
        }
    }
    __syncthreads();
}

constexpr int LDS_BYTES = pg8::STAGE_BYTES + 256 + 4096 + 1024;

enum { K_SWIGLU = 0, K_STORE = 1, K_NORM = 2, K_ROPE = 3, K_ATT = 4, K_GATE = 5, K_FNORM = 6, K_NONE = 7 };
constexpr int NOPS = 15;

__global__ void __launch_bounds__(NTHR) mega_fwd(Args args) {
    extern __shared__ __attribute__((aligned(16))) unsigned char lds[];
    cg::grid_group grid = cg::this_grid();
    Ctx C; C.wave = __builtin_amdgcn_readfirstlane(threadIdx.x >> 6);
    C.G = gridDim.x; { const int bx = blockIdx.x; C.vcu = (C.G % 8 == 0) ? (bx % 8) * (C.G / 8) + bx / 8 : bx; }
    C.gw = C.vcu * NWAVES + C.wave; C.NGW = C.G * NWAVES; C.ws = args.ws;
    LAS unsigned char* ldsl = (LAS unsigned char*)lds;
    unsigned char* ws = args.ws;
    bf16_t* H = (bf16_t*)(ws + WS_H); bf16_t* Y = (bf16_t*)(ws + WS_Y); bf16_t* T1 = (bf16_t*)(ws + WS_T1);
    bf16_t* BIG = (bf16_t*)(ws + WS_BIG); bf16_t* MRG = (bf16_t*)(ws + WS_MRG); bf16_t* KVM = (bf16_t*)(ws + WS_KVM); bf16_t* MEMN = (bf16_t*)(ws + WS_MEMN);
    const char* Wb = (const char*)(ws + WS_W);
    const float* x_in = (const float*)args.in[0];
    float* X = args.out;
    const int bid = (int)blockIdx.x;

    volatile LAS unsigned* bst = (volatile LAS unsigned*)(ldsl + pg8::STAGE_BYTES);
    if (threadIdx.x < 2) bst[threadIdx.x] = 0u;
    if (blockIdx.x == 0) { for (int i = threadIdx.x; i < XCD_BAR_WORDS; i += NTHR) __hip_atomic_store((unsigned*)ws + i, 0u, __ATOMIC_RELAXED, __HIP_MEMORY_SCOPE_AGENT); }
    if (blockIdx.x == 1) { for (int i = threadIdx.x; i < 128; i += NTHR) __hip_atomic_store((unsigned*)(ws + WS_XCNT) + 64 * i, 0u, __ATOMIC_RELAXED, __HIP_MEMORY_SCOPE_AGENT); }
    if (EN_CONV) convert_layer(C, args, ldsl, 0);
    if (EN_CONV) rope_table(C, args);
    float* RSTD = (float*)(ws + WS_RSTD);
    if (EN_NORM) norm_phase(C, x_in, H, nullptr, nullptr, 0.f, RSTD, nullptr);
    grid.sync();
    const XcdBarrier xbar = xcd_barrier_post((unsigned*)ws, bst);

#pragma unroll 1
    for (int step = 0; step < DEPTH * NOPS; ++step) {
        int l = step / NOPS, op = step - l * NOPS;
        asm volatile("" : "+s"(l), "+s"(op));
        int kind; bool sync = true;
        if (op == 0 || op == 12) kind = K_SWIGLU; else if (op == 3 || op == 11) kind = K_NONE; else if (op == 14) kind = K_NORM; else if (op == 4) kind = K_ROPE;
        else if (op == 5) kind = K_ATT; else if (op == 9) kind = K_GATE; else if (op == 2 || op == 10 || op == 13) kind = K_FNORM; else kind = K_STORE;
        if (op == 0 || op == 6 || op == 7 || op == 8 || op == 3 || op == 11) sync = false;
        if ((op == 13 || op == 14) && l == DEPTH - 1) sync = false;
        int reps = 1;
#if defined(PROBE_DUP_ATT)
        if (op == 5) reps = 2;
#endif
#if defined(PROBE_DUP_FFN)
        if (op == 0 || op == 2 || op == 12 || op == 13) reps = 2;
#endif
#if defined(PROBE_DUP_MIX)
        if (op == 4 || op == 6 || op == 7 || op == 8 || op == 10) reps = 2;
#endif
#pragma unroll 1
        for (int rep = 0; rep < reps; ++rep) {

        if (kind == K_SWIGLU) {
            pg8::Gemm g{H, (const bf16_t*)(Wb + (op == 0 ? W_UP1 : W_UP2)), DM, DM, NTOK, NUP, DM}; pg8::StaticOrder S; S.init(NTOK, NUP, C.G, bid);
            pg8::EpiSwiglu E{BIG, FF, RSTD}; if (EN_GEMM && EN_G1) pg8::gemm_phase<pg8::EpiSwiglu, true>(ldsl, g, S, E);
        } else if (kind == K_STORE) {
            pg8::Gemm g; pg8::EpiStore E;
            if (op == 1)       { g = pg8::Gemm{MEMN, (const bf16_t*)(Wb + W_KV), DM, DM, NBATCH * NMEM, 512, DM}; E = pg8::EpiStore{KVM, 512}; }
            else if (op == 6)  { g = pg8::Gemm{Y, (const bf16_t*)(Wb + W_BRP), DM, 256, NTOK, DM, 256}; E = pg8::EpiStore{BIG, 3072}; }
            else if (op == 7)  { g = pg8::Gemm{Y + 256, (const bf16_t*)(Wb + W_BRD), DM, 512, NTOK, DM, 512}; E = pg8::EpiStore{BIG + 1024, 3072}; }
            else               { g = pg8::Gemm{Y + 768, (const bf16_t*)(Wb + W_BRC), DM, 256, NTOK, DM, 256}; E = pg8::EpiStore{BIG + 2048, 3072}; }
            pg8::StaticOrder S; S.init(g.M, g.N, C.G, bid);
            if (EN_GEMM && EN_GS) pg8::gemm_phase<pg8::EpiStore, true>(ldsl, g, S, E);
        } else if (kind == K_ROPE) {
            pg8::Gemm g{H, (const bf16_t*)(Wb + W_IN), DM, DM, NTOK, INW, DM}; pg8::StaticOrder S; S.init(NTOK, INW, C.G, bid);
            pg8::EpiRope E{BIG, INW, (const float*)(ws + WS_ROPE), RSTD}; if (EN_GEMM && EN_GR) pg8::gemm_phase<pg8::EpiRope, true>(ldsl, g, S, E);
        } else if (kind == K_GATE) {
            pg8::Gemm g{H, (const bf16_t*)(Wb + W_GATE), DM, DM, NTOK, 3072, DM}; pg8::GateOrder S; S.base.init(NTOK, DM, C.G, bid);
            pg8::EpiGate E{BIG, MRG, (const float*)args.in[19] + (size_t)l * 3072, RSTD}; if (EN_GEMM && EN_GG) pg8::gemm_phase<pg8::EpiGate, true>(ldsl, g, S, E);
        } else if (kind == K_FNORM) {
            pg8::Gemm g;
            if (op == 2)       g = pg8::Gemm{BIG, (const bf16_t*)(Wb + W_DN1), FF, FF, NTOK, DM, FF};
            else if (op == 10) g = pg8::Gemm{MRG, (const bf16_t*)(Wb + W_OUT3), DM, DM, NTOK, DM, DM};
            else               g = pg8::Gemm{BIG, (const bf16_t*)(Wb + W_DN2), FF, FF, NTOK, DM, FF};
            const float* gpost = ((op == 2) ? (const float*)args.in[6] : (op == 10) ? (const float*)args.in[24] : (const float*)args.in[28]) + (size_t)l * DM;
            const bool last = (op == 13 && l + 1 == DEPTH);
            const unsigned seam = (unsigned)(l * 3 + (op == 2 ? 0 : op == 10 ? 1 : 2));
            pg8::PanelSsq x1{(float*)(ws + WS_XSLOT), (unsigned*)(ws + WS_XCNT), 16u * (seam + 1u)};
            pg8::EpiNorm E{H, last ? X : nullptr, gpost, (op == 10) ? 1.0f : 0.5f, RSTD, x1};
            pg8::StaticOrder S; S.init(NTOK, DM, C.G, bid);
            if (EN_GEMM) pg8::gemm_phase<pg8::EpiNorm, true>(ldsl, g, S, E);
        } else if (kind == K_NORM) {
            if (l + 1 < DEPTH) { if (EN_CONV) convert_layer(C, args, ldsl, l + 1); }
#if defined(PROBE_DUP_CONV)
            if (l + 1 < DEPTH) { convert_layer(C, args, ldsl, l + 1); convert_layer(C, args, ldsl, l + 1); }
#endif
        } else if (kind == K_NONE) {
        } else {
            const float* q1 = (const float*)args.in[11] + l * 64; const float* k1 = (const float*)args.in[12] + l * 64;
            const float* q2 = (const float*)args.in[13] + l * 64; const float* k2 = (const float*)args.in[14] + l * 64;
            const int lane_ = opaque_tid() & 63;
            float d1 = q1[lane_] * k1[lane_], d2 = q2[lane_] * k2[lane_];
            d1 = wave_sum(d1); d2 = wave_sum(d2);
            const float lam = __uint_as_float(__builtin_amdgcn_readfirstlane(__float_as_uint(expf(d1) - expf(d2) + (0.8f - 0.6f * expf(-0.3f * (float)l)))));
#pragma unroll 1
            for (int i = 0; i < 2; ++i) { const int u = C.vcu * 2 + i; if (EN_DA && u < NBATCH * 4 * 32) da_unit(C, args, (char*)lds, l, u >> 7, (u >> 5) & 3, u & 31, lam); }
#pragma unroll 1
            for (int i = 0; i < 2; ++i) { const int u = C.vcu * 2 + i; if (EN_CA && u < NBATCH * 4 * 32) ca_unit(C, (char*)lds, u >> 7, (u >> 5) & 3, u & 31); }
            if (EN_POOL) pool_phase(C, args, l);
        }
        }
        if (sync) xcd_barrier(xbar);
#if defined(PROBE_DUP_SYNC)
        if (sync) { xcd_barrier(xbar); xcd_barrier(xbar); xcd_barrier(xbar); xcd_barrier(xbar); }
#endif
    }
}

extern "C" void kernel_launch(void* const* d_in, const int* in_sizes, int n_in, void* d_out, int out_size, void* d_ws, size_t ws_size, hipStream_t stream) {
    static int grid = 0;
    if (grid == 0) {
        if (n_in != 29 || in_sizes[0] != NTOK * DM || out_size != NTOK * DM || ws_size < WS_TOTAL) {
            fprintf(stderr, "kernel_launch: unexpected shapes: n_in %d in0 %d out %d ws %zu (need %zu)\n", n_in, n_in > 0 ? in_sizes[0] : -1, out_size, ws_size, (size_t)WS_TOTAL); grid = -1; return; }
        int dev = 0, cus = 0, per_cu = 0;
        hipGetDevice(&dev); hipDeviceGetAttribute(&cus, hipDeviceAttributeMultiprocessorCount, dev);
        if (hipFuncSetAttribute((const void*)mega_fwd, hipFuncAttributeMaxDynamicSharedMemorySize, LDS_BYTES) != hipSuccess) { fprintf(stderr, "kernel_launch: hipFuncSetAttribute failed\n"); grid = -1; return; }
        if (hipOccupancyMaxActiveBlocksPerMultiprocessor(&per_cu, (const void*)mega_fwd, NTHR, LDS_BYTES) != hipSuccess || per_cu < 1) { fprintf(stderr, "kernel_launch: occupancy query says %d\n", per_cu); per_cu = 1; }
        (void)hipGetLastError();
        grid = cus;
        fprintf(stderr, "kernel_launch: grid %d (cus %d, per_cu %d)\n", grid, cus, per_cu);
    }
    if (grid < 0) return;
    Args a{};
    for (int i = 0; i < 29; ++i) a.in[i] = d_in[i];
    a.out = (float*)d_out; a.ws = (unsigned char*)d_ws;
    void* kargs[] = {&a};
    hipError_t e = hipLaunchCooperativeKernel((const void*)mega_fwd, dim3(grid), dim3(NTHR), kargs, LDS_BYTES, stream);
    if (e != hipSuccess) fprintf(stderr, "kernel_launch: cooperative launch failed: %s (grid %d)\n", hipGetErrorString(e), grid);
}
```

```cpp
#include <hip/hip_runtime.h>
#include <hip/hip_cooperative_groups.h>
#include <cstdio>
#include <cstdint>
namespace cg = cooperative_groups;
#ifndef EN_G1
#define EN_G1 1
#endif
#ifndef EN_GS
#define EN_GS 1
#endif
#ifndef EN_GR
#define EN_GR 1
#endif
#ifndef EN_GG
#define EN_GG 1
#endif
#ifndef EN_GEMM
#define EN_GEMM 1
#endif
#ifndef EN_DA
#define EN_DA 1
#endif
#ifndef EN_CA
#define EN_CA 1
#endif
#ifndef EN_POOL
#define EN_POOL 1
#endif
#ifndef EN_NORM
#define EN_NORM 1
#endif
#ifndef EN_CONV
#define EN_CONV 1
#endif

#define LAS __attribute__((address_space(3)))
typedef unsigned short bf16_t;
typedef short bf16x8 __attribute__((ext_vector_type(8)));
typedef short s16x4 __attribute__((ext_vector_type(4)));
typedef float f32x4 __attribute__((ext_vector_type(4)));
typedef float f32x2 __attribute__((ext_vector_type(2)));
typedef float f32x16 __attribute__((ext_vector_type(16)));
typedef unsigned u32x4 __attribute__((ext_vector_type(4)));
typedef unsigned u32x2 __attribute__((ext_vector_type(2)));

constexpr int NTOK = 32768, DM = 1024, SEQ = 8192, NBATCH = 4, FF = 2816, NUP = 5632, INW = 2048, NMEM = 256, DEPTH = 4;
constexpr float NORM_EPS = 1e-6f;
constexpr int NWAVES = 8, NTHR = 512;

constexpr size_t MiB = 1u << 20;
constexpr size_t WS_XCNT = 64 * 1024;
constexpr size_t WS_XSLOT = 6 * MiB;
constexpr size_t WS_RSTD = 7 * MiB;
constexpr size_t WS_ROPE = 1 * MiB;
constexpr size_t WS_MEMN = 3 * MiB;
constexpr size_t WS_KVM  = 5 * MiB;
constexpr size_t WS_W    = 8 * MiB;
constexpr size_t W_UP1 = 0, W_DN1 = W_UP1 + (size_t)NUP * DM * 2, W_IN = W_DN1 + (size_t)DM * FF * 2, W_GATE = W_IN + (size_t)INW * DM * 2,
                 W_BRP = W_GATE + (size_t)3072 * DM * 2, W_BRD = W_BRP + (size_t)DM * 256 * 2, W_BRC = W_BRD + (size_t)DM * 512 * 2,
                 W_OUT3 = W_BRC + (size_t)DM * 256 * 2, W_UP2 = W_OUT3 + (size_t)DM * 3072 * 2, W_DN2 = W_UP2 + (size_t)NUP * DM * 2,
                 W_KV = W_DN2 + (size_t)DM * FF * 2, W_POOL = W_KV + (size_t)512 * DM * 2, W_END = W_POOL + 4 * 64 * 64 * 2;
static_assert(WS_W + W_END <= 64 * MiB, "weights region");
constexpr size_t WS_H   = 64 * MiB;
constexpr size_t WS_Y   = 128 * MiB;
constexpr size_t WS_T1  = 192 * MiB;
constexpr size_t WS_BIG = 256 * MiB;
constexpr size_t WS_OT  = WS_BIG + 128 * MiB;
constexpr size_t WS_MRG = 448 * MiB;
constexpr size_t WS_TOTAL = 512 * MiB;

__device__ __forceinline__ unsigned cvt_pk_bf16(float lo, float hi) { unsigned r; asm volatile("v_cvt_pk_bf16_f32 %0, %1, %2" : "=v"(r) : "v"(lo), "v"(hi)); return r; }
__device__ __forceinline__ float bf_lo(unsigned u) { return __uint_as_float(u << 16); }
__device__ __forceinline__ float bf_hi(unsigned u) { return __uint_as_float(u & 0xffff0000u); }
__device__ __forceinline__ float wave_sum(float v) {
#pragma unroll
    for (int o = 1; o < 64; o <<= 1) v += __shfl_xor(v, o);
    return v;
}
__device__ __forceinline__ float sigmoidf_fast(float x) { return __builtin_amdgcn_rcpf(1.0f + __builtin_amdgcn_exp2f(-1.4426950408889634f * x)); }

namespace pg8 {
constexpr int BM = 256, BK = 64, HALF = 128, HTB = HALF * BK * 2, STAGE_BYTES = 8 * HTB, NXCD = 8, WGM = 8;
__host__ __device__ __forceinline__ int lds_byte(int r, int c) { const int st = (r >> 4) * 2 + (c >> 5), rr = r & 15, cc = c & 31, ob = rr * 64 + cc * 2; return st * 1024 + (ob ^ (((ob >> 9) & 1) << 5)); }
__host__ __device__ __forceinline__ void stage_rc(int b, int& R, int& C) { const int st = b / 1024, sb = b % 1024, swz = sb ^ (((sb >> 9) & 1) << 5); R = (st >> 1) * 16 + swz / 64; C = (st & 1) * 32 + (swz % 64) / 2; }
__host__ __device__ __forceinline__ int perm32(int rho) { const int n = rho >> 4, i = rho & 15; return 8 * (i >> 2) + 4 * n + (i & 3); }

struct Unit { int pm, pn; };
struct Gemm { const bf16_t* A; const bf16_t* Bt; int lda, ldb, M, N, K; };

struct StaticOrder {
    int nM, nN, nwg, G, c;
    __device__ void init(int M, int N, int G_, int c_) { nM = M / BM; nN = N / BM; nwg = nM * nN; G = G_; c = c_; }
    __device__ bool next(int i, Unit& u) const {
        const long L = (long)i * G + c; if (L >= nwg) return false;
        int wgid = (int)L; { const int q = nwg / NXCD, r = nwg % NXCD, xcd = wgid % NXCD, off = wgid / NXCD; wgid = (xcd < r ? xcd * (q + 1) : r * (q + 1) + (xcd - r) * q) + off; }
        const int nig = WGM * nN, gid = wgid / nig, fm = gid * WGM, gsz = (nM - fm) < WGM ? (nM - fm) : WGM;
        u.pm = fm + ((wgid % nig) % gsz); u.pn = (wgid % nig) / gsz; return true;
    }
};

struct EpiStore {
    static constexpr bool FUSED = false;
    bf16_t* O; int ldc;
    __device__ __forceinline__ void prefetch(const Unit&, int, int, float (&)[2][4]) const {}
    __device__ __forceinline__ void operator()(const f32x4 (&acc)[2][2][4][2], const Unit& u, int wr, int wc, int fr, int fq, const float (&)[2][4]) const {
        const int row0 = u.pm * BM + wr * 64 + fr, col0 = u.pn * BM + wc * 32 + 8 * fq;
#pragma unroll
        for (int ai = 0; ai < 2; ++ai)
#pragma unroll
            for (int m = 0; m < 4; ++m) { bf16_t* rowp = O + (size_t)(row0 + ai * HALF + m * 16) * ldc + col0;
#pragma unroll
                for (int bj = 0; bj < 2; ++bj) { const f32x4 v0 = acc[ai][bj][m][0], v1 = acc[ai][bj][m][1];
                    u32x4 w; w.x = cvt_pk_bf16(v0[0], v0[1]); w.y = cvt_pk_bf16(v0[2], v0[3]); w.z = cvt_pk_bf16(v1[0], v1[1]); w.w = cvt_pk_bf16(v1[2], v1[3]);
                    *(u32x4*)(rowp + bj * HALF) = w; } }
    }
};
struct EpiSwiglu {
    static constexpr bool FUSED = false;
    bf16_t* O; int ldc; const float* rstd;
    __device__ __forceinline__ void prefetch(const Unit& u, int wr, int fr, float (&rf)[2][4]) const {
        const int row0 = u.pm * BM + wr * 64 + fr;
#pragma unroll
        for (int ai = 0; ai < 2; ++ai)
#pragma unroll
            for (int m = 0; m < 4; ++m) { const f32x4 q4 = *(const f32x4*)(rstd + (size_t)(row0 + ai * HALF + m * 16) * 4); rf[ai][m] = 1.0f / sqrtf(((q4[0] + q4[1]) + (q4[2] + q4[3])) * (1.f / DM) + NORM_EPS); }
    }
    __device__ __forceinline__ void operator()(const f32x4 (&acc)[2][2][4][2], const Unit& u, int wr, int wc, int fr, int fq, const float (&rsv)[2][4]) const {
        const int row0 = u.pm * BM + wr * 64 + fr, col0 = u.pn * HALF + wc * 32 + 8 * fq;
#pragma unroll
        for (int ai = 0; ai < 2; ++ai)
#pragma unroll
            for (int m = 0; m < 4; ++m) { bf16_t* rowp = O + (size_t)(row0 + ai * HALF + m * 16) * ldc + col0;
                const float rs = rsv[ai][m];
                float h[8];
#pragma unroll
                for (int n = 0; n < 2; ++n)
#pragma unroll
                    for (int e = 0; e < 4; ++e) { const float a = acc[ai][0][m][n][e] * rs, b = acc[ai][1][m][n][e] * rs; h[n * 4 + e] = a * sigmoidf_fast(a) * b; }
                u32x4 w; w.x = cvt_pk_bf16(h[0], h[1]); w.y = cvt_pk_bf16(h[2], h[3]); w.z = cvt_pk_bf16(h[4], h[5]); w.w = cvt_pk_bf16(h[6], h[7]);
                *(u32x4*)rowp = w; }
    }
};
struct EpiRope {
    static constexpr bool FUSED = false;
    bf16_t* O; int ldc; const float* tab; const float* rstd;
    __device__ __forceinline__ void prefetch(const Unit& u, int wr, int fr, float (&rf)[2][4]) const {
        const int row0 = u.pm * BM + wr * 64 + fr;
#pragma unroll
        for (int ai = 0; ai < 2; ++ai)
#pragma unroll
            for (int m = 0; m < 4; ++m) { const f32x4 q4 = *(const f32x4*)(rstd + (size_t)(row0 + ai * HALF + m * 16) * 4); rf[ai][m] = 1.0f / sqrtf(((q4[0] + q4[1]) + (q4[2] + q4[3])) * (1.f / DM) + NORM_EPS); }
    }
    __device__ __forceinline__ void operator()(const f32x4 (&acc)[2][2][4][2], const Unit& u, int wr, int wc, int fr, int fq, const float (&rsv)[2][4]) const {
        const int row0 = u.pm * BM + wr * 64 + fr, col0 = u.pn * BM + wc * 32 + 8 * fq;
#pragma unroll
        for (int bj = 0; bj < 2; ++bj) {
            const int cw = u.pn * BM + bj * HALF + wc * 32;
            const bool rot = (cw >= 256) && (cw < 1280) && ((cw & 63) == 0);
#pragma unroll
            for (int ai = 0; ai < 2; ++ai)
#pragma unroll
                for (int m = 0; m < 4; ++m) { const int row = row0 + ai * HALF + m * 16;
                    const float rs = rsv[ai][m];
                    f32x4 v0 = acc[ai][bj][m][0] * rs, v1 = acc[ai][bj][m][1] * rs;
                    if (rot) {
                        const f32x4 c0 = *(const f32x4*)(tab + (size_t)row * 16), c1 = *(const f32x4*)(tab + (size_t)row * 16 + 4);
                        const f32x4 s0 = *(const f32x4*)(tab + (size_t)row * 16 + 8), s1 = *(const f32x4*)(tab + (size_t)row * 16 + 12);
                        f32x4 o0, o1;
#pragma unroll
                        for (int e = 0; e < 4; ++e) { o0[e] = __shfl_xor(v0[e], 16); o1[e] = __shfl_xor(v1[e], 16); }
                        const float sg = (fq == 0) ? -1.f : 1.f;
                        if (fq < 2) { v0 = v0 * c0 + (o0 * s0) * sg; v1 = v1 * c1 + (o1 * s1) * sg; }
                    }
                    u32x4 w; w.x = cvt_pk_bf16(v0[0], v0[1]); w.y = cvt_pk_bf16(v0[2], v0[3]); w.z = cvt_pk_bf16(v1[0], v1[1]); w.w = cvt_pk_bf16(v1[2], v1[3]);
                    *(u32x4*)(O + (size_t)row * ldc + col0 + bj * HALF) = w; }
        }
    }
};

struct PanelSsq {
    float* slots;
    unsigned* cnt;
    unsigned target;
    __device__ __forceinline__ void run(float (&part)[2][4], const Unit& u, int wr, int wc, int fr, int fq, LAS float* P, LAS float* S, int tid) const {
#pragma unroll
        for (int ai = 0; ai < 2; ++ai)
#pragma unroll
            for (int m = 0; m < 4; ++m) { float v = part[ai][m]; v += __shfl_xor(v, 16); v += __shfl_xor(v, 32);
                if (fq == 0) P[(ai * HALF + wr * 64 + m * 16 + fr) * 4 + wc] = v; }
        asm volatile("s_waitcnt lgkmcnt(0)" ::: "memory"); __builtin_amdgcn_s_barrier(); asm volatile("" ::: "memory");
        if (tid < 256) {
            const float sv = (P[tid * 4 + 0] + P[tid * 4 + 1]) + (P[tid * 4 + 2] + P[tid * 4 + 3]);
            __hip_atomic_store(slots + ((size_t)(u.pm * BM + tid) * 4 + u.pn), sv, __ATOMIC_RELAXED, __HIP_MEMORY_SCOPE_AGENT);
            asm volatile("s_waitcnt vmcnt(0)" ::: "memory");
            if ((tid & 63) == 0) __hip_atomic_fetch_add(cnt + 64 * u.pm, 1u, __ATOMIC_RELAXED, __HIP_MEMORY_SCOPE_AGENT);
        }
        if (tid < 64) {
            unsigned sp = 0;
            while ((unsigned)__builtin_amdgcn_readfirstlane(__hip_atomic_load(cnt + 64 * u.pm, __ATOMIC_RELAXED, __HIP_MEMORY_SCOPE_AGENT)) < target) {
                __builtin_amdgcn_s_sleep(2); if (++sp > (1u << 22)) break; }
            __builtin_amdgcn_fence(__ATOMIC_ACQUIRE, "agent");
        }
        asm volatile("s_waitcnt vmcnt(0) lgkmcnt(0)" ::: "memory"); __builtin_amdgcn_s_barrier(); asm volatile("" ::: "memory");
        if (tid < 256) {
            const float* sl = slots + (size_t)(u.pm * BM + tid) * 4;
            const float t0 = __hip_atomic_load(sl + 0, __ATOMIC_RELAXED, __HIP_MEMORY_SCOPE_AGENT), t1 = __hip_atomic_load(sl + 1, __ATOMIC_RELAXED, __HIP_MEMORY_SCOPE_AGENT);
            const float t2 = __hip_atomic_load(sl + 2, __ATOMIC_RELAXED, __HIP_MEMORY_SCOPE_AGENT), t3 = __hip_atomic_load(sl + 3, __ATOMIC_RELAXED, __HIP_MEMORY_SCOPE_AGENT);
            S[tid] = (t0 + t1) + (t2 + t3);
        }
        asm volatile("s_waitcnt vmcnt(0) lgkmcnt(0)" ::: "memory"); __builtin_amdgcn_s_barrier(); asm volatile("" ::: "memory");
    }
};
struct EpiNorm {
    static constexpr bool FUSED = true;
    bf16_t* XB; float* Fout; const float* gpost; float scale; float* ssq2; PanelSsq x1;
    __device__ __forceinline__ void prefetch(const Unit&, int, int, float (&)[2][4]) const {}
    __device__ __forceinline__ void fused(f32x4 (&acc)[2][2][4][2], const Unit& u, int wr, int wc, int fr, int fq, LAS unsigned char* xl, int tid) const {
        LAS float* P = (LAS float*)xl; LAS float* S = (LAS float*)(xl + 4096);
        const int col0 = u.pn * BM + wc * 32 + 8 * fq;
        float part[2][4];
#pragma unroll
        for (int ai = 0; ai < 2; ++ai)
#pragma unroll
            for (int m = 0; m < 4; ++m) { float q = 0.f;
#pragma unroll
                for (int bj = 0; bj < 2; ++bj)
#pragma unroll
                    for (int n = 0; n < 2; ++n) { const f32x4 v = acc[ai][bj][m][n]; q += (v[0] * v[0] + v[1] * v[1]) + (v[2] * v[2] + v[3] * v[3]); }
                part[ai][m] = q; }
        u32x4 xv[4][2];
#pragma unroll
        for (int m = 0; m < 4; ++m) { const size_t off = (size_t)(u.pm * BM + wr * 64 + m * 16 + fr) * DM + col0;
#pragma unroll
            for (int bj = 0; bj < 2; ++bj) xv[m][bj] = *(const u32x4*)(XB + off + bj * HALF); }
        x1.run(part, u, wr, wc, fr, fq, P, S, tid);
        f32x4 gp[2][2];
#pragma unroll
        for (int bj = 0; bj < 2; ++bj)
#pragma unroll
            for (int n = 0; n < 2; ++n) gp[bj][n] = *(const f32x4*)(gpost + col0 + bj * HALF + 4 * n);
#pragma unroll
        for (int ai = 0; ai < 2; ++ai)
#pragma unroll
            for (int m = 0; m < 4; ++m) { const int rl = ai * HALF + wr * 64 + m * 16 + fr; const size_t off = (size_t)(u.pm * BM + rl) * DM + col0;
                const float rs = scale / sqrtf(S[rl] * (1.f / DM) + NORM_EPS); float q = 0.f;
#pragma unroll
                for (int bj = 0; bj < 2; ++bj) { const u32x4 w = (ai == 0) ? xv[m][bj] : *(const u32x4*)(XB + off + bj * HALF);
                    const f32x4 x0 = (f32x4){bf_lo(w.x), bf_hi(w.x), bf_lo(w.y), bf_hi(w.y)}, x1v = (f32x4){bf_lo(w.z), bf_hi(w.z), bf_lo(w.w), bf_hi(w.w)};
                    const f32x4 n0 = x0 + acc[ai][bj][m][0] * rs * gp[bj][0], n1 = x1v + acc[ai][bj][m][1] * rs * gp[bj][1];
                    q += ((n0[0] * n0[0] + n0[1] * n0[1]) + (n0[2] * n0[2] + n0[3] * n0[3])) + ((n1[0] * n1[0] + n1[1] * n1[1]) + (n1[2] * n1[2] + n1[3] * n1[3]));
                    if (Fout) { *(f32x4*)(Fout + off + bj * HALF) = n0; *(f32x4*)(Fout + off + bj * HALF + 4) = n1; }
                    else { u32x4 o; o.x = cvt_pk_bf16(n0[0], n0[1]); o.y = cvt_pk_bf16(n0[2], n0[3]); o.z = cvt_pk_bf16(n1[0], n1[1]); o.w = cvt_pk_bf16(n1[2], n1[3]); *(u32x4*)(XB + off + bj * HALF) = o; } }
                part[ai][m] = q; }
        if (Fout) return;
#pragma unroll
        for (int ai = 0; ai < 2; ++ai)
#pragma unroll
            for (int m = 0; m < 4; ++m) { float v = part[ai][m]; v += __shfl_xor(v, 16); v += __shfl_xor(v, 32);
                if (fq == 0) P[(ai * HALF + wr * 64 + m * 16 + fr) * 4 + wc] = v; }
        asm volatile("s_waitcnt lgkmcnt(0)" ::: "memory"); __builtin_amdgcn_s_barrier(); asm volatile("" ::: "memory");
        if (tid < 256) ssq2[(size_t)(u.pm * BM + tid) * 4 + u.pn] = (P[tid * 4 + 0] + P[tid * 4 + 1]) + (P[tid * 4 + 2] + P[tid * 4 + 3]);
        asm volatile("s_waitcnt lgkmcnt(0)" ::: "memory"); __builtin_amdgcn_s_barrier(); asm volatile("" ::: "memory");
    }
};

struct GateOrder {
    StaticOrder base;
    __device__ bool next(int i, Unit& u) const { const int j = i / 3, b = i - 3 * j; if (!base.next(j, u)) return false; u.pn += 4 * b; return true; }
};
struct EpiGate {
    static constexpr bool FUSED = false;
    const bf16_t* PG; bf16_t* MRG; const float* bias; const float* rstd;
    __device__ __forceinline__ void prefetch(const Unit& u, int wr, int fr, float (&rf)[2][4]) const {
        const int row0 = u.pm * BM + wr * 64 + fr;
#pragma unroll
        for (int ai = 0; ai < 2; ++ai)
#pragma unroll
            for (int m = 0; m < 4; ++m) { const f32x4 q4 = *(const f32x4*)(rstd + (size_t)(row0 + ai * HALF + m * 16) * 4); rf[ai][m] = 1.0f / sqrtf(((q4[0] + q4[1]) + (q4[2] + q4[3])) * (1.f / DM) + NORM_EPS); }
    }
    __device__ __forceinline__ void operator()(const f32x4 (&acc)[2][2][4][2], const Unit& u, int wr, int wc, int fr, int fq, const float (&rsv)[2][4]) const {
        const int row0 = u.pm * BM + wr * 64 + fr, col0 = u.pn * BM + wc * 32 + 8 * fq, mcol0 = (u.pn & 3) * BM + wc * 32 + 8 * fq;
        const bool first = (u.pn < 4);
#pragma unroll
        for (int bj = 0; bj < 2; ++bj) {
            const f32x4 b0 = *(const f32x4*)(bias + col0 + bj * HALF), b1 = *(const f32x4*)(bias + col0 + bj * HALF + 4);
#pragma unroll
            for (int ai = 0; ai < 2; ++ai)
#pragma unroll
                for (int m = 0; m < 4; ++m) { const size_t row = (size_t)(row0 + ai * HALF + m * 16);
                    const u32x4 pv = __builtin_nontemporal_load((const u32x4*)(PG + row * 3072 + col0 + bj * HALF));
                    bf16_t* mp = MRG + row * DM + mcol0 + bj * HALF;
                    u32x4 mo = (u32x4){0u, 0u, 0u, 0u}; if (!first) mo = *(const u32x4*)mp;
                    const float rs = rsv[ai][m];
                    const f32x4 v0 = acc[ai][bj][m][0] * rs + b0, v1 = acc[ai][bj][m][1] * rs + b1;
                    const float g0 = sigmoidf_fast(v0[0]) * bf_lo(pv.x) + bf_lo(mo.x), g1 = sigmoidf_fast(v0[1]) * bf_hi(pv.x) + bf_hi(mo.x);
                    const float g2 = sigmoidf_fast(v0[2]) * bf_lo(pv.y) + bf_lo(mo.y), g3 = sigmoidf_fast(v0[3]) * bf_hi(pv.y) + bf_hi(mo.y);
                    const float g4 = sigmoidf_fast(v1[0]) * bf_lo(pv.z) + bf_lo(mo.z), g5 = sigmoidf_fast(v1[1]) * bf_hi(pv.z) + bf_hi(mo.z);
                    const float g6 = sigmoidf_fast(v1[2]) * bf_lo(pv.w) + bf_lo(mo.w), g7 = sigmoidf_fast(v1[3]) * bf_hi(pv.w) + bf_hi(mo.w);
                    u32x4 w; w.x = cvt_pk_bf16(g0, g1); w.y = cvt_pk_bf16(g2, g3); w.z = cvt_pk_bf16(g4, g5); w.w = cvt_pk_bf16(g6, g7);
                    *(u32x4*)mp = w; }
        }
    }
};

template <class Epi, bool ALIGN_EPI, class Sched>
__device__ __forceinline__ void gemm_phase(LAS unsigned char* lds, const Gemm g, const Sched& S, const Epi& E) {
    int tid = threadIdx.x; asm volatile("" : "+v"(tid));
    const int wid = __builtin_amdgcn_readfirstlane(tid >> 6), lane = tid & 63, wr = wid >> 2, wc = wid & 3, fr = lane & 15, fq = lane >> 4;
    const int nt = g.K / BK;
    unsigned voffA[2], voffB[2];
#pragma unroll
    for (int i = 0; i < 2; ++i) { int R, C; stage_rc(tid * 16 + i * 8192, R, C); const int Rb = (R & ~31) + perm32(R & 31);
        voffA[i] = (unsigned)(R * g.lda + C) * 2u; voffB[i] = (unsigned)(Rb * g.ldb + C) * 2u; }
    const size_t kstep = (size_t)(BK * 2);
    const size_t hstepA = (size_t)HALF * g.lda * 2, hstepB = (size_t)HALF * g.ldb * 2;
    const size_t tstepA = 2 * hstepA, tstepB = 2 * hstepB;
    const unsigned ldsw = (unsigned)wid * 1024u;
    const int aoff = lds_byte(wr * 64 + fr, fq * 8), boff = lds_byte(wc * 32 + fr, fq * 8);
#define PG8_SA(b, h) (((b) * 2 + (h)) * HTB)
#define PG8_SB(b, h) ((4 + (b) * 2 + (h)) * HTB)
#define PG8_STAGE(bufoff, gbase, voff) do { _Pragma("unroll") for (int _i = 0; _i < 2; ++_i) \
        __builtin_amdgcn_global_load_lds((const unsigned*)((const char*)(gbase) + (voff)[_i]), (LAS unsigned*)(lds + (bufoff) + ldsw + _i * 8192), 16, 0, 0); } while (0)
#define PG8_LDA(dst, b, h) do { _Pragma("unroll") for (int m = 0; m < 4; ++m) _Pragma("unroll") for (int k = 0; k < 2; ++k) dst[m][k] = *(const LAS bf16x8*)(lds + PG8_SA(b, h) + aoff + m * 2048 + k * 1024); } while (0)
#define PG8_LDB(dst, b, h) do { _Pragma("unroll") for (int n = 0; n < 2; ++n) _Pragma("unroll") for (int k = 0; k < 2; ++k) dst[n][k] = *(const LAS bf16x8*)(lds + PG8_SB(b, h) + boff + n * 2048 + k * 1024); } while (0)
#define PG8_MMA(ai, bj, At, Bt) do { __builtin_amdgcn_s_setprio(1); _Pragma("unroll") for (int m = 0; m < 4; ++m) _Pragma("unroll") for (int n = 0; n < 2; ++n) _Pragma("unroll") for (int k = 0; k < 2; ++k) \
        acc[ai][bj][m][n] = __builtin_amdgcn_mfma_f32_16x16x32_bf16(Bt[n][k], At[m][k], acc[ai][bj][m][n], 0, 0, 0); __builtin_amdgcn_s_setprio(0); } while (0)
#define PG8_WAIT_V(n) asm volatile("s_waitcnt vmcnt(" #n ")" ::: "memory")
#define PG8_WAIT_L(n) asm volatile("s_waitcnt lgkmcnt(" #n ")" ::: "memory")
#define PG8_BAR __builtin_amdgcn_s_barrier()
#define PG8_SCHED __builtin_amdgcn_sched_barrier(0)
    Unit cur, nxt; int ui = 0;
    if (!S.next(0, cur)) return;
    float rowf[2][4] = {}; E.prefetch(cur, wr, fr, rowf);
    f32x4 acc[2][2][4][2];
#pragma unroll
    for (int a = 0; a < 2; ++a)
#pragma unroll
        for (int b = 0; b < 2; ++b)
#pragma unroll
            for (int m = 0; m < 4; ++m)
#pragma unroll
                for (int n = 0; n < 2; ++n) acc[a][b][m][n] = (f32x4){0.f, 0.f, 0.f, 0.f};
    bf16x8 At[4][2], B0[2][2], B1[2][2];
    const char* cA = (const char*)g.A + (size_t)cur.pm * tstepA; const char* cB = (const char*)g.Bt + (size_t)cur.pn * tstepB;
    PG8_STAGE(PG8_SB(0, 0), cB, voffB); PG8_STAGE(PG8_SB(0, 1), cB + hstepB, voffB); PG8_STAGE(PG8_SA(0, 0), cA, voffA); PG8_STAGE(PG8_SA(0, 1), cA + hstepA, voffA);
    if (wr == 1) PG8_BAR;
    PG8_WAIT_V(2); PG8_BAR;
    PG8_STAGE(PG8_SB(1, 0), cB + kstep, voffB); PG8_STAGE(PG8_SA(1, 0), cA + kstep, voffA); PG8_STAGE(PG8_SB(1, 1), cB + hstepB + kstep, voffB);
    PG8_WAIT_V(6); PG8_BAR;
    for (;;) {
        const bool has_next = S.next(ui + 1, nxt);
        const char* nA = has_next ? (const char*)g.A + (size_t)nxt.pm * tstepA : cA; const char* nB = has_next ? (const char*)g.Bt + (size_t)nxt.pn * tstepB : cB;
        for (int t = 0; t < nt; t += 2) {
            const bool last = (t == nt - 2);
            const char* a1 = cA + (size_t)(t + 1) * kstep;
            const char* a2 = last ? nA : cA + (size_t)(t + 2) * kstep; const char* b2 = last ? nB : cB + (size_t)(t + 2) * kstep;
            const char* a3 = a2 + kstep; const char* b3 = b2 + kstep;
            PG8_LDB(B0, 0, 0); PG8_LDB(B1, 0, 1); PG8_SCHED; PG8_LDA(At, 0, 0); PG8_STAGE(PG8_SA(1, 1), a1 + hstepA, voffA);
            PG8_WAIT_V(8); PG8_WAIT_L(0); PG8_BAR; PG8_MMA(0, 0, At, B0); PG8_MMA(0, 1, At, B1); PG8_BAR; PG8_SCHED;
            PG8_LDA(At, 0, 1); PG8_STAGE(PG8_SB(0, 0), b2, voffB); PG8_STAGE(PG8_SB(0, 1), b2 + hstepB, voffB); PG8_STAGE(PG8_SA(0, 0), a2, voffA);
            PG8_WAIT_V(8); PG8_WAIT_L(0); PG8_BAR; PG8_MMA(1, 0, At, B0); PG8_MMA(1, 1, At, B1); PG8_BAR; PG8_SCHED;
            PG8_LDB(B0, 1, 0); PG8_LDB(B1, 1, 1); PG8_SCHED; PG8_LDA(At, 1, 0); PG8_STAGE(PG8_SA(0, 1), a2 + hstepA, voffA);
            PG8_WAIT_V(8); PG8_WAIT_L(0); PG8_BAR; PG8_MMA(0, 0, At, B0); PG8_MMA(0, 1, At, B1); PG8_BAR; PG8_SCHED;
            PG8_LDA(At, 1, 1); PG8_STAGE(PG8_SB(1, 0), b3, voffB); PG8_STAGE(PG8_SB(1, 1), b3 + hstepB, voffB); PG8_STAGE(PG8_SA(1, 0), a3, voffA);
            PG8_WAIT_V(8); PG8_WAIT_L(0); PG8_BAR; PG8_MMA(1, 0, At, B0); PG8_MMA(1, 1, At, B1); PG8_BAR; PG8_SCHED;
        }
        if constexpr (ALIGN_EPI) { if (wr == 0) PG8_BAR; }
        if constexpr (Epi::FUSED) E.fused(acc, cur, wr, wc, fr, fq, lds + STAGE_BYTES + 256, tid); else E(acc, cur, wr, wc, fr, fq, rowf);
        if (!has_next) break;
#pragma unroll
        for (int a = 0; a < 2; ++a)
#pragma unroll
            for (int b = 0; b < 2; ++b)
#pragma unroll
                for (int m = 0; m < 4; ++m)
#pragma unroll
                    for (int n = 0; n < 2; ++n) acc[a][b][m][n] = (f32x4){0.f, 0.f, 0.f, 0.f};
        cur = nxt; cA = nA; cB = nB; ++ui; E.prefetch(cur, wr, fr, rowf);
        if constexpr (ALIGN_EPI) { if (wr == 1) PG8_BAR; }
    }
    PG8_WAIT_V(0);
    if constexpr (!ALIGN_EPI) { if (wr == 0) PG8_BAR; }
    PG8_BAR;
#undef PG8_SA
#undef PG8_SB
#undef PG8_STAGE
#undef PG8_LDA
#undef PG8_LDB
#undef PG8_MMA
#undef PG8_WAIT_V
#undef PG8_WAIT_L
#undef PG8_BAR
#undef PG8_SCHED
}
}

namespace att {
#define SBAR() __builtin_amdgcn_sched_barrier(0)
#define SGB(mask, n) __builtin_amdgcn_sched_group_barrier((mask), (n), 0)
constexpr float SCALE = 0.125f;
constexpr float THR = 8.f;
constexpr int SHM_K = 64 * 64 * 2;
#define KSWZ(row, colB) ((row) * 128 + ((colB) ^ ((((row) >> 1) & 7) << 4)))
typedef __bf16 bf16x2_t __attribute__((ext_vector_type(2)));
typedef short v4i16_t __attribute__((ext_vector_type(4)));
typedef LAS const char* lds_cptr;
__device__ __forceinline__ int crow(int r, int hi) { return (r & 3) + 8 * (r >> 2) + 4 * hi; }
__device__ __forceinline__ unsigned cvtpk_s(float lo, float hi) { f32x2 v = {lo, hi}; bf16x2_t b = __builtin_convertvector(v, bf16x2_t); return __builtin_bit_cast(unsigned, b); }
__device__ __forceinline__ s16x4 vtr(lds_cptr p) { return __builtin_bit_cast(s16x4, __builtin_amdgcn_ds_read_tr16_b64_v4i16((LAS v4i16_t*)p)); }

__device__ __forceinline__ void psm_max(const f32x16& p0, const f32x16& p1, float& m_reg, float& alpha, float& mnC) {
    constexpr float C = SCALE * 1.4426950408889634f;
    float pa = fmaxf(fmaxf(p0[0], p0[1]), p1[0]), pb = fmaxf(fmaxf(p0[2], p0[3]), p1[1]); pa = fmaxf(fmaxf(pa, p1[2]), p1[3]);
#pragma unroll
    for (int r = 4; r < 16; r += 4) { pa = fmaxf(fmaxf(pa, p0[r]), p0[r + 1]); pb = fmaxf(fmaxf(pb, p0[r + 2]), p0[r + 3]); pa = fmaxf(fmaxf(pa, p1[r]), p1[r + 1]); pb = fmaxf(fmaxf(pb, p1[r + 2]), p1[r + 3]); }
    float pmax = fmaxf(pa, pb);
    { auto rr = __builtin_amdgcn_permlane32_swap(__float_as_uint(pmax), __float_as_uint(pmax), false, false);
      pmax = fmaxf(__uint_as_float(rr[0]), __uint_as_float(rr[1])); }
    const float mn = (pmax - m_reg > THR / SCALE) ? pmax : m_reg;
    alpha = __builtin_amdgcn_exp2f((m_reg - mn) * C); m_reg = mn;
    mnC = -mn * C;
}
__device__ __forceinline__ void psm_scale(f32x16& p0, f32x16& p1, float mnC) {
    constexpr float C = SCALE * 1.4426950408889634f;
#pragma unroll
    for (int r = 0; r < 16; ++r) p0[r] = fmaf(p0[r], C, mnC);
#pragma unroll
    for (int r = 0; r < 16; ++r) p1[r] = fmaf(p1[r], C, mnC);
}
template <int LO> __device__ __forceinline__ void psm_exp(f32x16& p0) {
#pragma unroll
    for (int r = LO; r < LO + 8; ++r) p0[r] = __builtin_amdgcn_exp2f(p0[r]);
}
__device__ __forceinline__ void partialSM(f32x16& p0, f32x16& p1, float& m_reg, float& alpha) {
    float mnC; psm_max(p0, p1, m_reg, alpha, mnC); psm_scale(p0, p1, mnC); psm_exp<0>(p0); psm_exp<8>(p0);
}
__device__ __forceinline__ void finishSM(f32x16& p0, f32x16& p1, float alpha, float& l_reg, bf16x8& pa0, bf16x8& pa1, bf16x8& pa2, bf16x8& pa3) {
#pragma unroll
    for (int r = 0; r < 16; ++r) p1[r] = __builtin_amdgcn_exp2f(p1[r]);
    float ps0 = 0.f, ps1 = 0.f;
#pragma unroll
    for (int r = 0; r < 16; ++r) { ps0 += p0[r]; ps1 += p1[r]; }
    float ps = ps0 + ps1;
    { auto rr = __builtin_amdgcn_permlane32_swap(__float_as_uint(ps), __float_as_uint(ps), false, false);
      ps = __uint_as_float(rr[0]) + __uint_as_float(rr[1]); }
    l_reg = l_reg * alpha + ps;
#define PK4(P, BASE, OUT) do { unsigned a0 = cvtpk_s(P[BASE + 0], P[BASE + 1]), a1 = cvtpk_s(P[BASE + 2], P[BASE + 3]);   \
    unsigned b0 = cvtpk_s(P[BASE + 4], P[BASE + 5]), b1 = cvtpk_s(P[BASE + 6], P[BASE + 7]);                              \
    auto r0 = __builtin_amdgcn_permlane32_swap(a0, b0, false, false); auto r1 = __builtin_amdgcn_permlane32_swap(a1, b1, false, false); \
    u32x4 w = {r0[0], r1[0], r0[1], r1[1]}; OUT = __builtin_bit_cast(bf16x8, w); } while (0)
    PK4(p0, 0, pa0); PK4(p0, 8, pa1); PK4(p1, 0, pa2); PK4(p1, 8, pa3);
#undef PK4
}
__device__ __forceinline__ void qkt(f32x16& p0, f32x16& p1, lds_cptr Ks, const bf16x8* qr, int r32, int hi) {
    p0 = f32x16{}; p1 = f32x16{};
    bf16x8 b0[4], b1[4];
#pragma unroll
    for (int d0 = 0; d0 < 4; ++d0) { const int cb = (d0 * 16 + hi * 8) * 2;
        b0[d0] = *reinterpret_cast<const LAS bf16x8*>(Ks + KSWZ(r32, cb));
        b1[d0] = *reinterpret_cast<const LAS bf16x8*>(Ks + KSWZ(32 + r32, cb)); }
#pragma unroll
    for (int d0 = 0; d0 < 4; ++d0) {
        p0 = __builtin_amdgcn_mfma_f32_32x32x16_bf16(b0[d0], qr[d0], p0, 0, 0, 0);
        p1 = __builtin_amdgcn_mfma_f32_32x32x16_bf16(b1[d0], qr[d0], p1, 0, 0, 0); }
}
template <int DV> __device__ __forceinline__ int v_st(int k, int c) { const int kk = (k & ~0xC) | ((k & 4) << 1) | ((k & 8) >> 1); return ((kk >> 3) * (DV / 32) + (c >> 5)) * 512 + ((kk & 7) * 32 + (c & 31)) * 2; }
__device__ __forceinline__ int v_rd_base(int lane) { return ((lane & 3) << 3) | (((lane >> 2) & 3) << 6) | (((lane >> 4) & 1) << 5) | (((lane >> 5) & 1) << 8); }
template <int DV> struct VFrag { s16x4 l[DV / 32], h[DV / 32]; };
template <int DV, int KS_IDX> __device__ __forceinline__ void v_rd(VFrag<DV>& f, lds_cptr vb) {
    constexpr int KS = DV * 32, HF = DV * 16;
#pragma unroll
    for (int d = 0; d < DV / 32; ++d) { f.l[d] = vtr(vb + d * 512 + KS_IDX * KS); f.h[d] = vtr(vb + d * 512 + KS_IDX * KS + HF); }
}
template <int DV> __device__ __forceinline__ void v_mma(f32x16* o, const VFrag<DV>& f, bf16x8 pa) {
#pragma unroll
    for (int d = 0; d < DV / 32; ++d) o[d] = __builtin_amdgcn_mfma_f32_32x32x16_bf16(pa, (bf16x8){f.l[d][0], f.l[d][1], f.l[d][2], f.l[d][3], f.h[d][0], f.h[d][1], f.h[d][2], f.h[d][3]}, o[d], 0, 0, 0);
}
template <int DV> __device__ __forceinline__ void pv_all(f32x16* o, lds_cptr vb, bf16x8 pa0, bf16x8 pa1, bf16x8 pa2, bf16x8 pa3) {
    VFrag<DV> A, B;
    v_rd<DV, 0>(A, vb); v_rd<DV, 1>(B, vb); v_mma<DV>(o, A, pa0);
    v_rd<DV, 2>(A, vb); v_mma<DV>(o, B, pa1);
    v_rd<DV, 3>(B, vb); v_mma<DV>(o, A, pa2);
    v_mma<DV>(o, B, pa3);
}
template <int DV> __device__ __forceinline__ void pv_psm(f32x16* o, lds_cptr vb, bf16x8 pa0, bf16x8 pa1, bf16x8 pa2, bf16x8 pa3, f32x16& p0, f32x16& p1, float& m_reg, float& alpha) {
    constexpr int ND = DV / 32, NV = (DV == 128) ? 8 : 16;
    VFrag<DV> A, B; float mnC;
    v_rd<DV, 0>(A, vb); SBAR();
    v_rd<DV, 1>(B, vb); v_mma<DV>(o, A, pa0); psm_max(p0, p1, m_reg, alpha, mnC);
    SGB(0x100, 2 * ND);
#pragma unroll
    for (int i = 0; i < ND; ++i) { SGB(0x008, 1); SGB(0x002, NV); }
    SBAR();
    v_rd<DV, 2>(A, vb); v_mma<DV>(o, B, pa1); psm_scale(p0, p1, mnC);
    SGB(0x100, 2 * ND);
#pragma unroll
    for (int i = 0; i < ND; ++i) { SGB(0x008, 1); SGB(0x002, NV); }
    SBAR();
    v_rd<DV, 3>(B, vb); v_mma<DV>(o, A, pa2); psm_exp<0>(p0);
    SGB(0x100, 2 * ND);
#pragma unroll
    for (int i = 0; i < ND; ++i) { SGB(0x008, 1); SGB(0x400, 8 / ND); }
    SBAR();
    v_mma<DV>(o, B, pa3); psm_exp<8>(p0);
#pragma unroll
    for (int i = 0; i < ND; ++i) { SGB(0x008, 1); SGB(0x400, 8 / ND); }
    asm volatile("" : "+v"(p0), "+v"(p1));
    SBAR();
}

template <int DV, int ldq, int ldk, int ldv>
__device__ __forceinline__ void attn_pass(const bf16_t* __restrict__ Qw, const bf16_t* __restrict__ Kh, const bf16_t* __restrict__ Vh,
                                          int NT, char* lds, f32x16 (&o)[DV / 32], float& l_out) {
    constexpr int ND = DV / 32, SHM_V = 64 * DV * 2, NVP = DV / 64;
    int tid = threadIdx.x; asm volatile("" : "+v"(tid));
    const int wid = __builtin_amdgcn_readfirstlane(tid >> 6), lane = tid & 63, r32 = lane & 31, hi = lane >> 5;
    const lds_cptr lds3 = (lds_cptr)lds;
    const lds_cptr V3 = lds3, K3 = lds3 + 4 * SHM_V;
    LAS float* al_l = (LAS float*)(lds3 + 4 * SHM_V + 4 * SHM_K) + wid * 64 + 32;
    LAS unsigned char* Vw = (LAS unsigned char*)lds3; LAS unsigned char* Kw = (LAS unsigned char*)lds3 + 4 * SHM_V;
    float m_reg = -1e30f, l_reg = 0; bf16x8 qr[4];
#pragma unroll
    for (int d = 0; d < ND; ++d) o[d] = f32x16{};
    const bf16_t* Ql = Qw + r32 * ldq + hi * 8;
#pragma unroll
    for (int d0 = 0; d0 < 4; ++d0) qr[d0] = *reinterpret_cast<const bf16x8*>(Ql + d0 * 16);
    const int krow = 8 * wid + (lane >> 3), kch = (lane & 7) ^ ((krow >> 1) & 7);
    const bf16_t* ksrc = Kh + krow * ldk + kch * 8;
    const bf16_t* vsrc[NVP];
#pragma unroll
    for (int i = 0; i < NVP; ++i) { const int p = (NVP * wid + i) * 64 + lane, st = p >> 5, kk = (st / (DV / 32)) * 8 + ((p >> 2) & 7);
        const int k = (kk & ~0xC) | ((kk & 4) << 1) | ((kk & 8) >> 1), c = (st % (DV / 32)) * 32 + (p & 3) * 8; vsrc[i] = Vh + k * ldv + c; }
    const lds_cptr vb0 = V3 + v_rd_base(lane);
#define DMA(t, slot) do { __builtin_amdgcn_global_load_lds((const unsigned*)(ksrc + (size_t)(t) * 64 * ldk), (LAS unsigned*)(Kw + (slot) * SHM_K + wid * 1024), 16, 0, 0); \
    _Pragma("unroll") for (int _i = 0; _i < NVP; ++_i) __builtin_amdgcn_global_load_lds((const unsigned*)(vsrc[_i] + (size_t)(t) * 64 * ldv), (LAS unsigned*)(Vw + (slot) * SHM_V + (NVP * wid + _i) * 1024), 16, 0, 0); } while (0)
#define RESC(a) do { if (__any((a) < 1.f)) { if (hi == 0) al_l[r32] = (a); \
    _Pragma("unroll") for (int d = 0; d < ND; ++d) _Pragma("unroll") for (int r = 0; r < 16; ++r) o[d][r] *= al_l[crow(r, hi)]; } } while (0)
#define HINT_R1() do { SGB(0x100, 8); _Pragma("unroll") for (int _i = 0; _i < 8; ++_i) { SGB(0x008, 1); SGB(0x400, 2); SGB(0x002, 10); } } while (0)
#define DRAIN_BAR() do { asm volatile("s_waitcnt vmcnt(0) lgkmcnt(0)\n\ts_barrier" ::: "memory"); } while (0)
#define COUNT_BAR() do { if constexpr (DV == 128) asm volatile("s_waitcnt vmcnt(3) lgkmcnt(0)\n\ts_barrier" ::: "memory"); else asm volatile("s_waitcnt vmcnt(2) lgkmcnt(0)\n\ts_barrier" ::: "memory"); } while (0)
    f32x16 pA0, pA1, pB0, pB1; float alA, alB; bf16x8 pa0, pa1, pa2, pa3;
    DMA(0, 0); DMA(1, 1); DMA(2, 2); DRAIN_BAR();
    qkt(pA0, pA1, K3, qr, r32, hi); partialSM(pA0, pA1, m_reg, alA);
#define BODY(Pc0, Pc1, alc, Pn0, Pn1, aln, j) do { \
        const bool more_ = ((j) + 3 < NT); \
        if (more_) DMA((j) + 3, ((j) + 3) & 3); \
        SBAR(); qkt(Pn0, Pn1, K3 + (((j) + 1) & 3) * SHM_K, qr, r32, hi); \
        finishSM(Pc0, Pc1, alc, l_reg, pa0, pa1, pa2, pa3); HINT_R1(); SBAR(); \
        pv_psm<DV>(o, vb0 + ((j) & 3) * SHM_V, pa0, pa1, pa2, pa3, Pn0, Pn1, m_reg, aln); \
        RESC(aln); if (more_) COUNT_BAR(); else DRAIN_BAR(); } while (0)
    for (int j = 0; j + 2 < NT; j += 2) {
        BODY(pA0, pA1, alA, pB0, pB1, alB, j);
        BODY(pB0, pB1, alB, pA0, pA1, alA, j + 1);
    }
    BODY(pA0, pA1, alA, pB0, pB1, alB, NT - 2);
    finishSM(pB0, pB1, alB, l_reg, pa0, pa1, pa2, pa3); SBAR();
    pv_all<DV>(o, vb0 + ((NT - 1) & 3) * SHM_V, pa0, pa1, pa2, pa3);
    l_out = l_reg;
    __syncthreads();
#undef DMA
#undef RESC
#undef HINT_R1
#undef DRAIN_BAR
#undef COUNT_BAR
#undef BODY
}
template <int DV> __device__ __forceinline__ void row_rcp(char* lds, float l_reg, float (&rli)[16]) {
    int tid = threadIdx.x; asm volatile("" : "+v"(tid));
    const int wid = tid >> 6, lane = tid & 63, r32 = lane & 31, hi = lane >> 5;
    LAS float* li_l = (LAS float*)((lds_cptr)lds + 4 * (64 * DV * 2) + 4 * SHM_K) + wid * 64;
    if (hi == 0) li_l[r32] = l_reg;
#pragma unroll
    for (int r = 0; r < 16; ++r) rli[r] = __builtin_amdgcn_rcpf(li_l[crow(r, hi)]);
}
}

struct Args { const void* in[29]; float* out; unsigned char* ws; };

struct Ctx {
    int wave, vcu, G, gw, NGW;
    unsigned char* ws;
};
__device__ __forceinline__ int opaque_tid() { int t = threadIdx.x; asm volatile("" : "+v"(t)); return t; }

__device__ __forceinline__ void transpose_item(const float* W, int N, bf16_t* WT, int ldt, int coff, int mode, LAS float* scr, int item, int lane, const float* gk = nullptr) {
    const int nblk = N / 32, kb = item / nblk, nb = item % nblk, k0 = 64 * kb, n0 = 32 * nb;
    float wv[32];
#pragma unroll
    for (int i = 0; i < 32; ++i) { const int kk = 2 * i + (lane >> 5); wv[i] = __builtin_nontemporal_load(W + (size_t)(k0 + kk) * N + n0 + (lane & 31)); }
    if (gk) {
#pragma unroll
        for (int i = 0; i < 32; ++i) wv[i] *= gk[k0 + 2 * i + (lane >> 5)]; }
#pragma unroll
    for (int i = 0; i < 32; ++i) { const int kk = 2 * i + (lane >> 5); scr[kk * 33 + (lane & 31)] = wv[i]; }
    asm volatile("s_waitcnt lgkmcnt(0)" ::: "memory");
    int d0 = n0;
    if (mode == 1) d0 = (n0 < FF) ? ((n0 >> 7) * 256 + (n0 & 127)) : (((n0 - FF) >> 7) * 256 + 128 + ((n0 - FF) & 127));
    const int c = lane & 7;
#pragma unroll
    for (int j = 0; j < 4; ++j) { const int n = (lane >> 3) + 8 * j; const LAS float* s = scr + (8 * c) * 33 + n;
        u32x4 o; o.x = cvt_pk_bf16(s[0 * 33], s[1 * 33]); o.y = cvt_pk_bf16(s[2 * 33], s[3 * 33]); o.z = cvt_pk_bf16(s[4 * 33], s[5 * 33]); o.w = cvt_pk_bf16(s[6 * 33], s[7 * 33]);
        *(u32x4*)(WT + (size_t)(d0 + n) * ldt + coff + k0 + 8 * c) = o; }
    asm volatile("s_waitcnt lgkmcnt(0)" ::: "memory");
}

__device__ __forceinline__ void convert_layer(const Ctx& C, const Args& A, LAS unsigned char* lds, int l) {
    const int lane = opaque_tid() & 63;
    LAS float* scr = (LAS float*)(lds + C.wave * 16384);
    unsigned char* wb = C.ws + WS_W;
    const float* up1 = (const float*)A.in[4] + (size_t)l * DM * NUP;  const float* dn1 = (const float*)A.in[5] + (size_t)l * FF * DM;
    const float* win = (const float*)A.in[8] + (size_t)l * DM * INW;  const float* wg = (const float*)A.in[18] + (size_t)l * DM * 3072;
    const float* brp = (const float*)A.in[20] + (size_t)l * 256 * DM; const float* brd = (const float*)A.in[21] + (size_t)l * 512 * DM;
    const float* brc = (const float*)A.in[22] + (size_t)l * 256 * DM; const float* wo = (const float*)A.in[23] + (size_t)l * DM * DM;
    const float* up2 = (const float*)A.in[26] + (size_t)l * DM * NUP; const float* dn2 = (const float*)A.in[27] + (size_t)l * FF * DM;
    const float* g_f1 = (const float*)A.in[3] + (size_t)l * DM; const float* g_mx = (const float*)A.in[7] + (size_t)l * DM; const float* g_f2 = (const float*)A.in[25] + (size_t)l * DM;
    const float* wkv = (const float*)A.in[17] + (size_t)l * DM * 512; const float* pw = (const float*)A.in[9] + (size_t)l * 4 * 64 * 64;
    constexpr int I_UP = (DM / 64) * (NUP / 32), I_DN = (FF / 64) * (DM / 32), I_IN = (DM / 64) * (INW / 32), I_G = (DM / 64) * (3072 / 32),
                  I_BP = (256 / 64) * (DM / 32), I_BD = (512 / 64) * (DM / 32), I_O = (DM / 64) * (DM / 32), I_KV = (DM / 64) * (512 / 32), I_PW = 2;
    constexpr int NITEMS = 2 * I_UP + 2 * I_DN + I_IN + I_G + 2 * I_BP + I_BD + I_O + I_KV + 4 * I_PW;
    for (int it = C.gw; it < NITEMS; it += C.NGW) {
        int r = it;
#define TR(Wp, Kk, Nn, WTo, ldt, coff, mode, NI) if (r < (NI)) { transpose_item((Wp), (Nn), (bf16_t*)(wb + (WTo)), (ldt), (coff), (mode), scr, r, lane); continue; } r -= (NI);
#define TRG(Wp, Kk, Nn, WTo, ldt, coff, mode, NI, G) if (r < (NI)) { transpose_item((Wp), (Nn), (bf16_t*)(wb + (WTo)), (ldt), (coff), (mode), scr, r, lane, (G)); continue; } r -= (NI);
        TRG(up1, DM, NUP, W_UP1, DM, 0, 1, I_UP, g_f1)
        TRG(up2, DM, NUP, W_UP2, DM, 0, 1, I_UP, g_f2)
        TR(dn1, FF, DM, W_DN1, FF, 0, 0, I_DN)
        TR(dn2, FF, DM, W_DN2, FF, 0, 0, I_DN)
        TRG(win, DM, INW, W_IN, DM, 0, 0, I_IN, g_mx)
        TRG(wg, DM, 3072, W_GATE, DM, 0, 0, I_G, g_mx)
        TR(brp, 256, DM, W_BRP, 256, 0, 0, I_BP)
        TR(brd, 512, DM, W_BRD, 512, 0, 0, I_BD)
        TR(brc, 256, DM, W_BRC, 256, 0, 0, I_BP)
        TR(wo, DM, DM, W_OUT3, DM, 0, 0, I_O)
        TR(wkv, DM, 512, W_KV, DM, 0, 0, I_KV)
        TR(pw, 64, 64, W_POOL, 64, 0, 0, I_PW)
        TR(pw + 4096, 64, 64, W_POOL + 8192, 64, 0, 0, I_PW)
        TR(pw + 8192, 64, 64, W_POOL + 16384, 64, 0, 0, I_PW)
        TR(pw + 12288, 64, 64, W_POOL + 24576, 64, 0, 0, I_PW)
#undef TR
#undef TRG
    }
    const float* mem = (const float*)A.in[1]; const float* mg = (const float*)A.in[16] + (size_t)l * DM; bf16_t* memn = (bf16_t*)(C.ws + WS_MEMN);
    for (int row = C.gw; row < NBATCH * NMEM; row += C.NGW) {
        const f32x4* xr = (const f32x4*)(mem + (size_t)row * DM) + lane; f32x4 v[4]; float ss = 0.f;
#pragma unroll
        for (int j = 0; j < 4; ++j) { v[j] = xr[64 * j]; ss += (v[j].x * v[j].x + v[j].y * v[j].y) + (v[j].z * v[j].z + v[j].w * v[j].w); }
        const float rs = 1.0f / sqrtf(wave_sum(ss) * (1.f / DM) + NORM_EPS);
#pragma unroll
        for (int j = 0; j < 4; ++j) { const f32x4 gg = *((const f32x4*)mg + lane + 64 * j); const f32x4 t = v[j] * rs * gg;
            u32x2 w; w.x = cvt_pk_bf16(t.x, t.y); w.y = cvt_pk_bf16(t.z, t.w); *((u32x2*)(memn + (size_t)row * DM) + lane + 64 * j) = w; }
    }
}

__device__ __forceinline__ void norm_phase(const Ctx& C, const float* Xf, bf16_t* XB, const bf16_t* T1, const float* gpost, float scale, float* rstd, float* Fout, bf16_t* XBo = nullptr) {
    if (XBo == nullptr) XBo = XB;
    const int lane = opaque_tid() & 63;
    for (int row0 = C.gw; row0 < NTOK; row0 += 2 * C.NGW) {
        f32x4 v[2][4]; u32x2 tw[2][4];
#pragma unroll
        for (int q = 0; q < 2; ++q) { const int row = row0 + q * C.NGW;
            if (Xf) {
#pragma unroll
                for (int j = 0; j < 4; ++j) v[q][j] = __builtin_nontemporal_load((const f32x4*)(Xf + (size_t)row * DM) + lane + 64 * j);
            } else {
#pragma unroll
                for (int j = 0; j < 4; ++j) { const u32x2 w = *((const u32x2*)(XB + (size_t)row * DM) + lane + 64 * j); v[q][j] = (f32x4){bf_lo(w.x), bf_hi(w.x), bf_lo(w.y), bf_hi(w.y)}; }
            }
            if (T1) {
#pragma unroll
                for (int j = 0; j < 4; ++j) tw[q][j] = __builtin_nontemporal_load((const u32x2*)(T1 + (size_t)row * DM) + lane + 64 * j);
            } }
#pragma unroll
        for (int q = 0; q < 2; ++q) { const int row = row0 + q * C.NGW;
            if (T1) {
                f32x4 t[4]; float ss = 0.f;
#pragma unroll
                for (int j = 0; j < 4; ++j) { const u32x2 w = tw[q][j];
                    t[j] = (f32x4){bf_lo(w.x), bf_hi(w.x), bf_lo(w.y), bf_hi(w.y)}; ss += (t[j].x * t[j].x + t[j].y * t[j].y) + (t[j].z * t[j].z + t[j].w * t[j].w); }
                const float rs = scale / sqrtf(wave_sum(ss) * (1.f / DM) + NORM_EPS);
#pragma unroll
                for (int j = 0; j < 4; ++j) { const f32x4 gg = *((const f32x4*)gpost + lane + 64 * j); v[q][j] = v[q][j] + t[j] * rs * gg; }
            }
            if (Fout) {
#pragma unroll
                for (int j = 0; j < 4; ++j) __builtin_nontemporal_store(v[q][j], (f32x4*)(Fout + (size_t)row * DM) + lane + 64 * j);
            } else {
                float ss = 0.f;
#pragma unroll
                for (int j = 0; j < 4; ++j) { ss += (v[q][j].x * v[q][j].x + v[q][j].y * v[q][j].y) + (v[q][j].z * v[q][j].z + v[q][j].w * v[q][j].w);
                    u32x2 w; w.x = cvt_pk_bf16(v[q][j].x, v[q][j].y); w.y = cvt_pk_bf16(v[q][j].z, v[q][j].w); *((u32x2*)(XBo + (size_t)row * DM) + lane + 64 * j) = w; }
                const float st = wave_sum(ss);
                if (lane == 0) *(f32x4*)(rstd + (size_t)row * 4) = (f32x4){st, 0.f, 0.f, 0.f};
            }
        }
    }
}

__device__ __forceinline__ void rope_table(const Ctx& C, const Args& A) {
    const int* pos = (const int*)A.in[2]; float* tab = (float*)(C.ws + WS_ROPE);
    const int tid = opaque_tid();
    for (int idx = blockIdx.x * NTHR + tid; idx < NTOK * 8; idx += C.G * NTHR) {
        const int row = idx >> 3, i = idx & 7;
        const double inv = (i == 0) ? 1.0 : (i == 1) ? 0.19392274474868576 : (i == 2) ? 0.03760603093086393 : (i == 3) ? 0.007292664737217109 :
                           (i == 4) ? 0.001414213562373095 : (i == 5) ? 0.0002742481756762073 : (i == 6) ? 5.318295896944988e-05 : 1.031338537721246e-05;
        const double rev = (double)pos[row] * inv * 0.15915494309189535;
        const float fr = (float)(rev - __builtin_rint(rev));
        tab[(size_t)row * 16 + i] = __builtin_amdgcn_cosf(fr); tab[(size_t)row * 16 + 8 + i] = __builtin_amdgcn_sinf(fr);
    }
}

template <int G>
__device__ __forceinline__ void pool_item(const bf16_t* INP, bf16_t* Y, const bf16_t* PWT, const float* pscale, int rb, int r32, int hi) {
    constexpr int W2 = 1 << G;
    const int row = rb * 32 + r32, s = row & (SEQ - 1), b0 = row - s;
    const int lo = (s - W2 < 0) ? 0 : s - W2, hi_ = (s + W2 > SEQ) ? SEQ : s + W2;
    const float rc = 1.0f / (float)(hi_ - lo);
    f32x16 a0 = f32x16{}, a1 = f32x16{};
#pragma unroll
    for (int ks = 0; ks < 4; ++ks) {
        const int ch = G * 64 + ks * 16 + hi * 8;
        u32x4 w[2 * W2];
#pragma unroll
        for (int jj = 0; jj < 2 * W2; ++jj) { int j = s - W2 + jj; j = j < 0 ? 0 : (j > SEQ - 1 ? SEQ - 1 : j); w[jj] = *(const u32x4*)(INP + (size_t)(b0 + j) * INW + ch); }
        float sum[8];
#pragma unroll
        for (int e = 0; e < 8; ++e) sum[e] = 0.f;
#pragma unroll
        for (int jj = 0; jj < 2 * W2; ++jj) { const int j = s - W2 + jj; const float m = (j >= 0 && j < SEQ) ? 1.f : 0.f;
            sum[0] += m * bf_lo(w[jj].x); sum[1] += m * bf_hi(w[jj].x); sum[2] += m * bf_lo(w[jj].y); sum[3] += m * bf_hi(w[jj].y);
            sum[4] += m * bf_lo(w[jj].z); sum[5] += m * bf_hi(w[jj].z); sum[6] += m * bf_lo(w[jj].w); sum[7] += m * bf_hi(w[jj].w); }
        const u32x4 uw = w[W2];
        const float u[8] = {bf_lo(uw.x), bf_hi(uw.x), bf_lo(uw.y), bf_hi(uw.y), bf_lo(uw.z), bf_hi(uw.z), bf_lo(uw.w), bf_hi(uw.w)};
        u32x4 pa; pa.x = cvt_pk_bf16(sum[0] * rc - u[0], sum[1] * rc - u[1]); pa.y = cvt_pk_bf16(sum[2] * rc - u[2], sum[3] * rc - u[3]);
        pa.z = cvt_pk_bf16(sum[4] * rc - u[4], sum[5] * rc - u[5]); pa.w = cvt_pk_bf16(sum[6] * rc - u[6], sum[7] * rc - u[7]);
        const bf16x8 af = *reinterpret_cast<bf16x8*>(&pa);
        const bf16x8 w0 = *reinterpret_cast<const bf16x8*>(PWT + (size_t)G * 4096 + (size_t)r32 * 64 + ks * 16 + hi * 8);
        const bf16x8 w1 = *reinterpret_cast<const bf16x8*>(PWT + (size_t)G * 4096 + (size_t)(32 + r32) * 64 + ks * 16 + hi * 8);
        a0 = __builtin_amdgcn_mfma_f32_32x32x16_bf16(af, w0, a0, 0, 0, 0);
        a1 = __builtin_amdgcn_mfma_f32_32x32x16_bf16(af, w1, a1, 0, 0, 0);
    }
    const float sc0 = pscale[G * 64 + r32], sc1 = pscale[G * 64 + 32 + r32];
#pragma unroll
    for (int r = 0; r < 16; ++r) { bf16_t* yp = Y + (size_t)(rb * 32 + att::crow(r, hi)) * DM + G * 64 + r32;
        yp[0] = (bf16_t)(cvt_pk_bf16(a0[r] * sc0, 0.f) & 0xffffu); yp[32] = (bf16_t)(cvt_pk_bf16(a1[r] * sc1, 0.f) & 0xffffu); }
}
__device__ __forceinline__ void pool_phase(const Ctx& C, const Args& A, int l) {
    const bf16_t* INP = (const bf16_t*)(C.ws + WS_BIG); bf16_t* Y = (bf16_t*)(C.ws + WS_Y);
    const bf16_t* PWT = (const bf16_t*)(C.ws + WS_W + W_POOL);
    const float* pscale = (const float*)A.in[10] + (size_t)l * 256;
    const int lane = opaque_tid() & 63, r32 = lane & 31, hi = lane >> 5;
    for (int it = C.gw, k = 0; it < (NTOK / 32) * 4; it += C.NGW, ++k) {
        const int rb = it >> 2, g = (it + k) & 3;
        if (g == 0) pool_item<0>(INP, Y, PWT, pscale, rb, r32, hi);
        else if (g == 1) pool_item<1>(INP, Y, PWT, pscale, rb, r32, hi);
        else if (g == 2) pool_item<2>(INP, Y, PWT, pscale, rb, r32, hi);
        else pool_item<3>(INP, Y, PWT, pscale, rb, r32, hi);
    }
}

__device__ __forceinline__ void da_unit(const Ctx& C, const Args& A, char* lds, int l, int b, int h, int qb, float lam) {
    const bf16_t* INP = (const bf16_t*)(C.ws + WS_BIG); bf16_t* Y = (bf16_t*)(C.ws + WS_Y);
    const size_t rowb = (size_t)b * SEQ;
    unsigned st[32];
#pragma unroll
    for (int i = 0; i < 32; ++i) st[i] = 0u;
#pragma unroll 1
    for (int c = 0; c < 2; ++c) {
        f32x16 o[4]; float l_reg; float rli[16];
        {
            const int wid0 = __builtin_amdgcn_readfirstlane(threadIdx.x >> 6);
            const size_t row0 = rowb + (size_t)qb * 256 + wid0 * 32;
            const bf16_t* Vh = INP + rowb * INW + 1280 + h * 128;
            const bf16_t* Qw = INP + row0 * INW + 256 + (h * 2 + c) * 64; const bf16_t* Kh = INP + rowb * INW + 768 + (h * 2 + c) * 64;
            att::attn_pass<128, INW, INW, INW>(Qw, Kh, Vh, SEQ / 64, lds, o, l_reg);
        }
        att::row_rcp<128>(lds, l_reg, rli);
        if (c == 0) {
#pragma unroll
            for (int d0 = 0; d0 < 4; ++d0)
#pragma unroll
                for (int r = 0; r < 16; r += 2) st[d0 * 8 + (r >> 1)] = cvt_pk_bf16(o[d0][r] * rli[r], o[d0][r + 1] * rli[r + 1]);
        } else {
            int tid = threadIdx.x; asm volatile("" : "+v"(tid));
            const int wid = tid >> 6, lane = tid & 63, r32 = lane & 31, hi = lane >> 5;
            const size_t row0 = rowb + (size_t)qb * 256 + wid * 32;
            const float* sg = (const float*)A.in[15] + (size_t)l * 128;
            const float lam_init = 0.8f - 0.6f * expf(-0.3f * (float)l);
            float gcol[4];
#pragma unroll
            for (int d0 = 0; d0 < 4; ++d0) gcol[d0] = sg[d0 * 32 + r32] * (1.0f - lam_init);
            bf16_t* Yw = Y + (row0 + 4 * hi) * DM + 256 + h * 128 + r32;
#pragma unroll
            for (int r = 0; r < 16; ++r) { float ss = 0.f; float v[4];
#pragma unroll
                for (int d0 = 0; d0 < 4; ++d0) { const unsigned w = st[d0 * 8 + (r >> 1)]; const float o0 = (r & 1) ? bf_hi(w) : bf_lo(w);
                    v[d0] = o0 - lam * (o[d0][r] * rli[r]); ss += v[d0] * v[d0]; }
#pragma unroll
                for (int off = 1; off < 32; off <<= 1) ss += __shfl_xor(ss, off);
                const float rs = 1.0f / sqrtf(ss * (1.f / 128.f) + NORM_EPS);
#pragma unroll
                for (int d0 = 0; d0 < 4; ++d0) Yw[((r & 3) + 8 * (r >> 2)) * DM + d0 * 32] = (bf16_t)(cvt_pk_bf16(v[d0] * rs * gcol[d0], 0.f) & 0xffffu);
                asm volatile("" ::: "memory"); }
        }
    }
}
__device__ __forceinline__ void ca_unit(const Ctx& C, char* lds, int b, int h, int qb) {
    const bf16_t* INP = (const bf16_t*)(C.ws + WS_BIG); bf16_t* Y = (bf16_t*)(C.ws + WS_Y); const bf16_t* KVM = (const bf16_t*)(C.ws + WS_KVM);
    const int tid = opaque_tid(), wid = tid >> 6, lane = tid & 63, r32 = lane & 31, hi = lane >> 5;
    const size_t row0 = (size_t)b * SEQ + (size_t)qb * 256 + wid * 32;
    const bf16_t* Qw = INP + row0 * INW + 1792 + h * 64;
    const bf16_t* Kh = KVM + (size_t)b * NMEM * 512 + h * 64; const bf16_t* Vh = Kh + 256;
    f32x16 o[2]; float l_reg; float rli[16];
    att::attn_pass<64, INW, 512, 512>(Qw, Kh, Vh, NMEM / 64, lds, o, l_reg);
    att::row_rcp<64>(lds, l_reg, rli);
#pragma unroll
    for (int r = 0; r < 16; ++r) { bf16_t* yp = Y + (row0 + att::crow(r, hi)) * DM + 768 + h * 64 + r32;
#pragma unroll
        for (int d0 = 0; d0 < 2; ++d0) yp[d0 * 32] = (bf16_t)(cvt_pk_bf16(o[d0][r] * rli[r], 0.f) & 0xffffu); }
}


#define XB_TMO      128
#define XB_XCNT(j)  (256  + 64 * (j))
#define XB_XSUB(j)  (1280 + 64 * (j))
#define XB_XGEN(j)  (2304 + 64 * (j))
#define XB_TOP      3328
#define XB_TOPGEN   3392
#define XCD_BAR_WORDS 3456
#define XB_SPIN_CAP (1u << 20)
__device__ __forceinline__ unsigned xb_ld(unsigned* p)              { return __hip_atomic_load(p, __ATOMIC_RELAXED, __HIP_MEMORY_SCOPE_AGENT); }
__device__ __forceinline__ unsigned xb_add(unsigned* p, unsigned v) { return __hip_atomic_fetch_add(p, v, __ATOMIC_RELAXED, __HIP_MEMORY_SCOPE_AGENT); }
__device__ __forceinline__ unsigned xb_xcc_id() { return (unsigned)__builtin_amdgcn_s_getreg((3 << 11) | 20) & 0xFu; }
#define XB_SPIN(cond, bar) do { unsigned _sp = 0; while (cond) { __builtin_amdgcn_s_sleep(1); \
    if ((++_sp & 255u) == 0u) { if (xb_ld(&(bar)[XB_TMO])) break; if (_sp > XB_SPIN_CAP) { atomicAdd(&(bar)[XB_TMO], 1u); break; } } } } while (0)
struct XcdBarrier { unsigned* bar; unsigned x; volatile LAS unsigned* st; };
__device__ __forceinline__ XcdBarrier xcd_barrier_post(unsigned* bar, volatile LAS unsigned* st) {
    XcdBarrier b; b.bar = bar; b.x = xb_xcc_id(); b.st = st;
    if (threadIdx.x == 0) (void)xb_add(&bar[XB_XCNT(b.x)], 1u);
    return b;
}
__device__ __forceinline__ void xcd_barrier_complete(unsigned* bar, unsigned x, unsigned& nloc, unsigned& nx) {
    const unsigned G = gridDim.x * gridDim.y * gridDim.z;
    unsigned sum, cnt, mine, sp = 0u;
    for (;;) {
        sum = 0u; cnt = 0u; mine = 0u;
#pragma unroll
        for (unsigned j = 0; j < 16; ++j) { const unsigned c = xb_ld(&bar[XB_XCNT(j)]); sum += c; cnt += (c > 0u) ? 1u : 0u; mine = (j == x) ? c : mine; }
        if (sum == G) break;
        __builtin_amdgcn_s_sleep(1);
        if ((++sp & 255u) == 0u) { if (xb_ld(&bar[XB_TMO])) break; if (sp > XB_SPIN_CAP) { atomicAdd(&bar[XB_TMO], 1u); break; } }
    }
    nloc = mine > 0u ? mine : 1u; nx = cnt > 0u ? cnt : 1u;
}
__device__ __forceinline__ void xcd_barrier(const XcdBarrier& b) {
    asm volatile("s_waitcnt vmcnt(0)" ::: "memory");
    __syncthreads();
    if (threadIdx.x == 0) {
        unsigned* bar = b.bar;
        __builtin_amdgcn_s_waitcnt(0);
        unsigned nloc = b.st[0], nx = b.st[1];
        if (nloc == 0u) { xcd_barrier_complete(bar, b.x, nloc, nx); b.st[0] = nloc; b.st[1] = nx; }
        const unsigned old = xb_add(&bar[XB_XSUB(b.x)], 1u);
        const unsigned gen = old / nloc;
        if (old + 1u == (gen + 1u) * nloc) {
            __builtin_amdgcn_fence(__ATOMIC_RELEASE, "agent");
            asm volatile("s_waitcnt vmcnt(0)" ::: "memory");
            const unsigned og = xb_add(&bar[XB_TOP], 1u);
            const unsigned tg = og / nx;
            if (og + 1u == (tg + 1u) * nx) xb_add(&bar[XB_TOPGEN], 1u);
            else XB_SPIN(xb_ld(&bar[XB_TOPGEN]) == tg, bar);
            __builtin_amdgcn_fence(__ATOMIC_ACQUIRE, "agent");
            xb_add(&bar[XB_XGEN(b.x)], 1u);
            asm volatile("s_waitcnt vmcnt(0)" ::: "memory");
        } else {
            XB_SPIN(xb_ld(&bar[XB_XGEN(b.x)]) == gen, bar);
            __builtin_amdgcn_fence(__ATOMIC_ACQUIRE, "agent");
            asm volatile("s_waitcnt vmcnt(0)" ::: "memory");
        }
    }
    __syncthreads();
}

constexpr int LDS_BYTES = pg8::STAGE_BYTES + 256 + 4096 + 1024;

enum { K_SWIGLU = 0, K_STORE = 1, K_NORM = 2, K_ROPE = 3, K_ATT = 4, K_GATE = 5, K_FNORM = 6, K_NONE = 7 };
constexpr int NOPS = 15;

__global__ void __launch_bounds__(NTHR) mega_fwd(Args args) {
    extern __shared__ __attribute__((aligned(16))) unsigned char lds[];
    cg::grid_group grid = cg::this_grid();
    Ctx C; C.wave = __builtin_amdgcn_readfirstlane(threadIdx.x >> 6);
    C.G = gridDim.x; { const int bx = blockIdx.x; C.vcu = (C.G % 8 == 0) ? (bx % 8) * (C.G / 8) + bx / 8 : bx; }
    C.gw = C.vcu * NWAVES + C.wave; C.NGW = C.G * NWAVES; C.ws = args.ws;
    LAS unsigned char* ldsl = (LAS unsigned char*)lds;
    unsigned char* ws = args.ws;
    bf16_t* H = (bf16_t*)(ws + WS_H); bf16_t* Y = (bf16_t*)(ws + WS_Y); bf16_t* T1 = (bf16_t*)(ws + WS_T1);
    bf16_t* BIG = (bf16_t*)(ws + WS_BIG); bf16_t* MRG = (bf16_t*)(ws + WS_MRG); bf16_t* KVM = (bf16_t*)(ws + WS_KVM); bf16_t* MEMN = (bf16_t*)(ws + WS_MEMN);
    const char* Wb = (const char*)(ws + WS_W);
    const float* x_in = (const float*)args.in[0];
    float* X = args.out;
    const int bid = (int)blockIdx.x;

    volatile LAS unsigned* bst = (volatile LAS unsigned*)(ldsl + pg8::STAGE_BYTES);
    if (threadIdx.x < 2) bst[threadIdx.x] = 0u;
    if (blockIdx.x == 0) { for (int i = threadIdx.x; i < XCD_BAR_WORDS; i += NTHR) __hip_atomic_store((unsigned*)ws + i, 0u, __ATOMIC_RELAXED, __HIP_MEMORY_SCOPE_AGENT); }
    if (blockIdx.x == 1) { for (int i = threadIdx.x; i < 128; i += NTHR) __hip_atomic_store((unsigned*)(ws + WS_XCNT) + 64 * i, 0u, __ATOMIC_RELAXED, __HIP_MEMORY_SCOPE_AGENT); }
    if (EN_CONV) convert_layer(C, args, ldsl, 0);
    if (EN_CONV) rope_table(C, args);
    float* RSTD = (float*)(ws + WS_RSTD);
    if (EN_NORM) norm_phase(C, x_in, H, nullptr, nullptr, 0.f, RSTD, nullptr);
    grid.sync();
    const XcdBarrier xbar = xcd_barrier_post((unsigned*)ws, bst);

#pragma unroll 1
    for (int step = 0; step < DEPTH * NOPS; ++step) {
        int l = step / NOPS, op = step - l * NOPS;
        asm volatile("" : "+s"(l), "+s"(op));
        int kind; bool sync = true;
        if (op == 0 || op == 12) kind = K_SWIGLU; else if (op == 3 || op == 11) kind = K_NONE; else if (op == 14) kind = K_NORM; else if (op == 4) kind = K_ROPE;
        else if (op == 5) kind = K_ATT; else if (op == 9) kind = K_GATE; else if (op == 2 || op == 10 || op == 13) kind = K_FNORM; else kind = K_STORE;
        if (op == 0 || op == 6 || op == 7 || op == 8 || op == 3 || op == 11) sync = false;
        if ((op == 13 || op == 14) && l == DEPTH - 1) sync = false;
        int reps = 1;
#if defined(PROBE_DUP_ATT)
        if (op == 5) reps = 2;
#endif
#if defined(PROBE_DUP_FFN)
        if (op == 0 || op == 2 || op == 12 || op == 13) reps = 2;
#endif
#if defined(PROBE_DUP_MIX)
        if (op == 4 || op == 6 || op == 7 || op == 8 || op == 10) reps = 2;
#endif
#pragma unroll 1
        for (int rep = 0; rep < reps; ++rep) {

        if (kind == K_SWIGLU) {
            pg8::Gemm g{H, (const bf16_t*)(Wb + (op == 0 ? W_UP1 : W_UP2)), DM, DM, NTOK, NUP, DM}; pg8::StaticOrder S; S.init(NTOK, NUP, C.G, bid);
            pg8::EpiSwiglu E{BIG, FF, RSTD}; if (EN_GEMM && EN_G1) pg8::gemm_phase<pg8::EpiSwiglu, true>(ldsl, g, S, E);
        } else if (kind == K_STORE) {
            pg8::Gemm g; pg8::EpiStore E;
            if (op == 1)       { g = pg8::Gemm{MEMN, (const bf16_t*)(Wb + W_KV), DM, DM, NBATCH * NMEM, 512, DM}; E = pg8::EpiStore{KVM, 512}; }
            else if (op == 6)  { g = pg8::Gemm{Y, (const bf16_t*)(Wb + W_BRP), DM, 256, NTOK, DM, 256}; E = pg8::EpiStore{BIG, 3072}; }
            else if (op == 7)  { g = pg8::Gemm{Y + 256, (const bf16_t*)(Wb + W_BRD), DM, 512, NTOK, DM, 512}; E = pg8::EpiStore{BIG + 1024, 3072}; }
            else               { g = pg8::Gemm{Y + 768, (const bf16_t*)(Wb + W_BRC), DM, 256, NTOK, DM, 256}; E = pg8::EpiStore{BIG + 2048, 3072}; }
            pg8::StaticOrder S; S.init(g.M, g.N, C.G, bid);
            if (EN_GEMM && EN_GS) pg8::gemm_phase<pg8::EpiStore, true>(ldsl, g, S, E);
        } else if (kind == K_ROPE) {
            pg8::Gemm g{H, (const bf16_t*)(Wb + W_IN), DM, DM, NTOK, INW, DM}; pg8::StaticOrder S; S.init(NTOK, INW, C.G, bid);
            pg8::EpiRope E{BIG, INW, (const float*)(ws + WS_ROPE), RSTD}; if (EN_GEMM && EN_GR) pg8::gemm_phase<pg8::EpiRope, true>(ldsl, g, S, E);
        } else if (kind == K_GATE) {
            pg8::Gemm g{H, (const bf16_t*)(Wb + W_GATE), DM, DM, NTOK, 3072, DM}; pg8::GateOrder S; S.base.init(NTOK, DM, C.G, bid);
            pg8::EpiGate E{BIG, MRG, (const float*)args.in[19] + (size_t)l * 3072, RSTD}; if (EN_GEMM && EN_GG) pg8::gemm_phase<pg8::EpiGate, true>(ldsl, g, S, E);
        } else if (kind == K_FNORM) {
            pg8::Gemm g;
            if (op == 2)       g = pg8::Gemm{BIG, (const bf16_t*)(Wb + W_DN1), FF, FF, NTOK, DM, FF};
            else if (op == 10) g = pg8::Gemm{MRG, (const bf16_t*)(Wb + W_OUT3), DM, DM, NTOK, DM, DM};
            else               g = pg8::Gemm{BIG, (const bf16_t*)(Wb + W_DN2), FF, FF, NTOK, DM, FF};
            const float* gpost = ((op == 2) ? (const float*)args.in[6] : (op == 10) ? (const float*)args.in[24] : (const float*)args.in[28]) + (size_t)l * DM;
            const bool last = (op == 13 && l + 1 == DEPTH);
            const unsigned seam = (unsigned)(l * 3 + (op == 2 ? 0 : op == 10 ? 1 : 2));
            pg8::PanelSsq x1{(float*)(ws + WS_XSLOT), (unsigned*)(ws + WS_XCNT), 16u * (seam + 1u)};
            pg8::EpiNorm E{H, last ? X : nullptr, gpost, (op == 10) ? 1.0f : 0.5f, RSTD, x1};
            pg8::StaticOrder S; S.init(NTOK, DM, C.G, bid);
            if (EN_GEMM) pg8::gemm_phase<pg8::EpiNorm, true>(ldsl, g, S, E);
        } else if (kind == K_NORM) {
            if (l + 1 < DEPTH) { if (EN_CONV) convert_layer(C, args, ldsl, l + 1); }
#if defined(PROBE_DUP_CONV)
            if (l + 1 < DEPTH) { convert_layer(C, args, ldsl, l + 1); convert_layer(C, args, ldsl, l + 1); }
#endif
        } else if (kind == K_NONE) {
        } else {
            const float* q1 = (const float*)args.in[11] + l * 64; const float* k1 = (const float*)args.in[12] + l * 64;
            const float* q2 = (const float*)args.in[13] + l * 64; const float* k2 = (const float*)args.in[14] + l * 64;
            const int lane_ = opaque_tid() & 63;
            float d1 = q1[lane_] * k1[lane_], d2 = q2[lane_] * k2[lane_];
            d1 = wave_sum(d1); d2 = wave_sum(d2);
            const float lam = __uint_as_float(__builtin_amdgcn_readfirstlane(__float_as_uint(expf(d1) - expf(d2) + (0.8f - 0.6f * expf(-0.3f * (float)l)))));
#pragma unroll 1
            for (int i = 0; i < 2; ++i) { const int u = C.vcu * 2 + i; if (EN_DA && u < NBATCH * 4 * 32) da_unit(C, args, (char*)lds, l, u >> 7, (u >> 5) & 3, u & 31, lam); }
#pragma unroll 1
            for (int i = 0; i < 2; ++i) { const int u = C.vcu * 2 + i; if (EN_CA && u < NBATCH * 4 * 32) ca_unit(C, (char*)lds, u >> 7, (u >> 5) & 3, u & 31); }
            if (EN_POOL) pool_phase(C, args, l);
        }
        }
        if (sync) xcd_barrier(xbar);
#if defined(PROBE_DUP_SYNC)
        if (sync) { xcd_barrier(xbar); xcd_barrier(xbar); xcd_barrier(xbar); xcd_barrier(xbar); }
#endif
    }
}

extern "C" void kernel_launch(void* const* d_in, const int* in_sizes, int n_in, void* d_out, int out_size, void* d_ws, size_t ws_size, hipStream_t stream) {
    static int grid = 0;
    if (grid == 0) {
        if (n_in != 29 || in_sizes[0] != NTOK * DM || out_size != NTOK * DM || ws_size < WS_TOTAL) {
            fprintf(stderr, "kernel_launch: unexpected shapes: n_in %d in0 %d out %d ws %zu (need %zu)\n", n_in, n_in > 0 ? in_sizes[0] : -1, out_size, ws_size, (size_t)WS_TOTAL); grid = -1; return; }
        int dev = 0, cus = 0, per_cu = 0;
        hipGetDevice(&dev); hipDeviceGetAttribute(&cus, hipDeviceAttributeMultiprocessorCount, dev);
        if (hipFuncSetAttribute((const void*)mega_fwd, hipFuncAttributeMaxDynamicSharedMemorySize, LDS_BYTES) != hipSuccess) { fprintf(stderr, "kernel_launch: hipFuncSetAttribute failed\n"); grid = -1; return; }
        if (hipOccupancyMaxActiveBlocksPerMultiprocessor(&per_cu, (const void*)mega_fwd, NTHR, LDS_BYTES) != hipSuccess || per_cu < 1) { fprintf(stderr, "kernel_launch: occupancy query says %d\n", per_cu); per_cu = 1; }
        (void)hipGetLastError();
        grid = cus;
        fprintf(stderr, "kernel_launch: grid %d (cus %d, per_cu %d)\n", grid, cus, per_cu);
    }
    if (grid < 0) return;
    Args a{};
    for (int i = 0; i < 29; ++i) a.in[i] = d_in[i];
    a.out = (float*)d_out; a.ws = (unsigned char*)d_ws;
    void* kargs[] = {&a};
    hipError_t e = hipLaunchCooperativeKernel((const void*)mega_fwd, dim3(grid), dim3(NTHR), kargs, LDS_BYTES, stream);
    if (e != hipSuccess) fprintf(stderr, "kernel_launch: cooperative launch failed: %s (grid %d)\n", hipGetErrorString(e), grid);
}
```

```cpp
#include <hip/hip_runtime.h>
#include <hip/hip_cooperative_groups.h>
#include <cstdio>
#include <cstdint>
namespace cg = cooperative_groups;
#ifndef EN_G1
#define EN_G1 1
#endif
#ifndef EN_GS
#define EN_GS 1
#endif
#ifndef EN_GR
#define EN_GR 1
#endif
#ifndef EN_GG
#define EN_GG 1
#endif
#ifndef EN_GEMM
#define EN_GEMM 1
#endif
#ifndef EN_DA
#define EN_DA 1
#endif
#ifndef EN_CA
#define EN_CA 1
#endif
#ifndef EN_POOL
#define EN_POOL 1
#endif
#ifndef EN_NORM
#define EN_NORM 1
#endif
#ifndef EN_CONV
#define EN_CONV 1
#endif

#define LAS __attribute__((address_space(3)))
typedef unsigned short bf16_t;
typedef short bf16x8 __attribute__((ext_vector_type(8)));
typedef short s16x4 __attribute__((ext_vector_type(4)));
typedef float f32x4 __attribute__((ext_vector_type(4)));
typedef float f32x2 __attribute__((ext_vector_type(2)));
typedef float f32x16 __attribute__((ext_vector_type(16)));
typedef unsigned u32x4 __attribute__((ext_vector_type(4)));
typedef unsigned u32x2 __attribute__((ext_vector_type(2)));

constexpr int NTOK = 32768, DM = 1024, SEQ = 8192, NBATCH = 4, FF = 2816, NUP = 5632, INW = 2048, NMEM = 256, DEPTH = 4;
constexpr float NORM_EPS = 1e-6f;
constexpr int NWAVES = 8, NTHR = 512;

constexpr size_t MiB = 1u << 20;
constexpr size_t WS_XCNT = 64 * 1024;
constexpr size_t WS_XSLOT = 6 * MiB;
constexpr size_t WS_RSTD = 7 * MiB;
constexpr size_t WS_ROPE = 1 * MiB;
constexpr size_t WS_MEMN = 3 * MiB;
constexpr size_t WS_KVM  = 5 * MiB;
constexpr size_t WS_W    = 8 * MiB;
constexpr size_t W_UP1 = 0, W_DN1 = W_UP1 + (size_t)NUP * DM * 2, W_IN = W_DN1 + (size_t)DM * FF * 2, W_GATE = W_IN + (size_t)INW * DM * 2,
                 W_BRP = W_GATE + (size_t)3072 * DM * 2, W_BRD = W_BRP + (size_t)DM * 256 * 2, W_BRC = W_BRD + (size_t)DM * 512 * 2,
                 W_OUT3 = W_BRC + (size_t)DM * 256 * 2, W_UP2 = W_OUT3 + (size_t)DM * 3072 * 2, W_DN2 = W_UP2 + (size_t)NUP * DM * 2,
                 W_KV = W_DN2 + (size_t)DM * FF * 2, W_POOL = W_KV + (size_t)512 * DM * 2, W_END = W_POOL + 4 * 64 * 64 * 2;
static_assert(WS_W + W_END <= 64 * MiB, "weights region");
constexpr size_t WS_H   = 64 * MiB;
constexpr size_t WS_Y   = 128 * MiB;
constexpr size_t WS_T1  = 192 * MiB;
constexpr size_t WS_BIG = 256 * MiB;
constexpr size_t WS_OT  = WS_BIG + 128 * MiB;
constexpr size_t WS_MRG = 448 * MiB;
constexpr size_t WS_TOTAL = 512 * MiB;

__device__ __forceinline__ unsigned cvt_pk_bf16(float lo, float hi) { unsigned r; asm volatile("v_cvt_pk_bf16_f32 %0, %1, %2" : "=v"(r) : "v"(lo), "v"(hi)); return r; }
__device__ __forceinline__ float bf_lo(unsigned u) { return __uint_as_float(u << 16); }
__device__ __forceinline__ float bf_hi(unsigned u) { return __uint_as_float(u & 0xffff0000u); }
__device__ __forceinline__ float wave_sum(float v) {
#pragma unroll
    for (int o = 1; o < 64; o <<= 1) v += __shfl_xor(v, o);
    return v;
}
__device__ __forceinline__ float sigmoidf_fast(float x) { return __builtin_amdgcn_rcpf(1.0f + __builtin_amdgcn_exp2f(-1.4426950408889634f * x)); }

namespace pg8 {
constexpr int BM = 256, BK = 64, HALF = 128, HTB = HALF * BK * 2, STAGE_BYTES = 8 * HTB, NXCD = 8, WGM = 8;
__host__ __device__ __forceinline__ int lds_byte(int r, int c) { const int st = (r >> 4) * 2 + (c >> 5), rr = r & 15, cc = c & 31, ob = rr * 64 + cc * 2; return st * 1024 + (ob ^ (((ob >> 9) & 1) << 5)); }
__host__ __device__ __forceinline__ void stage_rc(int b, int& R, int& C) { const int st = b / 1024, sb = b % 1024, swz = sb ^ (((sb >> 9) & 1) << 5); R = (st >> 1) * 16 + swz / 64; C = (st & 1) * 32 + (swz % 64) / 2; }
__host__ __device__ __forceinline__ int perm32(int rho) { const int n = rho >> 4, i = rho & 15; return 8 * (i >> 2) + 4 * n + (i & 3); }

struct Unit { int pm, pn; };
struct Gemm { const bf16_t* A; const bf16_t* Bt; int lda, ldb, M, N, K; };

struct StaticOrder {
    int nM, nN, nwg, G, c;
    __device__ void init(int M, int N, int G_, int c_) { nM = M / BM; nN = N / BM; nwg = nM * nN; G = G_; c = c_; }
    __device__ bool next(int i, Unit& u) const {
        const long L = (long)i * G + c; if (L >= nwg) return false;
        int wgid = (int)L; { const int q = nwg / NXCD, r = nwg % NXCD, xcd = wgid % NXCD, off = wgid / NXCD; wgid = (xcd < r ? xcd * (q + 1) : r * (q + 1) + (xcd - r) * q) + off; }
        const int nig = WGM * nN, gid = wgid / nig, fm = gid * WGM, gsz = (nM - fm) < WGM ? (nM - fm) : WGM;
        u.pm = fm + ((wgid % nig) % gsz); u.pn = (wgid % nig) / gsz; return true;
    }
};

struct EpiStore {
    static constexpr bool FUSED = false;
    bf16_t* O; int ldc;
    __device__ __forceinline__ void prefetch(const Unit&, int, int, float (&)[2][4]) const {}
    __device__ __forceinline__ void operator()(const f32x4 (&acc)[2][2][4][2], const Unit& u, int wr, int wc, int fr, int fq, const float (&)[2][4]) const {
        const int row0 = u.pm * BM + wr * 64 + fr, col0 = u.pn * BM + wc * 32 + 8 * fq;
#pragma unroll
        for (int ai = 0; ai < 2; ++ai)
#pragma unroll
            for (int m = 0; m < 4; ++m) { bf16_t* rowp = O + (size_t)(row0 + ai * HALF + m * 16) * ldc + col0;
#pragma unroll
                for (int bj = 0; bj < 2; ++bj) { const f32x4 v0 = acc[ai][bj][m][0], v1 = acc[ai][bj][m][1];
                    u32x4 w; w.x = cvt_pk_bf16(v0[0], v0[1]); w.y = cvt_pk_bf16(v0[2], v0[3]); w.z = cvt_pk_bf16(v1[0], v1[1]); w.w = cvt_pk_bf16(v1[2], v1[3]);
                    *(u32x4*)(rowp + bj * HALF) = w; } }
    }
};
struct EpiSwiglu {
    static constexpr bool FUSED = false;
    bf16_t* O; int ldc; const float* rstd;
    __device__ __forceinline__ void prefetch(const Unit& u, int wr, int fr, float (&rf)[2][4]) const {
        const int row0 = u.pm * BM + wr * 64 + fr;
#pragma unroll
        for (int ai = 0; ai < 2; ++ai)
#pragma unroll
            for (int m = 0; m < 4; ++m) { const f32x4 q4 = *(const f32x4*)(rstd + (size_t)(row0 + ai * HALF + m * 16) * 4); rf[ai][m] = __builtin_amdgcn_rsqf(((q4[0] + q4[1]) + (q4[2] + q4[3])) * (1.f / DM) + NORM_EPS); }
    }
    __device__ __forceinline__ void operator()(const f32x4 (&acc)[2][2][4][2], const Unit& u, int wr, int wc, int fr, int fq, const float (&rsv)[2][4]) const {
        const int row0 = u.pm * BM + wr * 64 + fr, col0 = u.pn * HALF + wc * 32 + 8 * fq;
#pragma unroll
        for (int ai = 0; ai < 2; ++ai)
#pragma unroll
            for (int m = 0; m < 4; ++m) { bf16_t* rowp = O + (size_t)(row0 + ai * HALF + m * 16) * ldc + col0;
                const float rs = rsv[ai][m];
                float h[8];
#pragma unroll
                for (int n = 0; n < 2; ++n)
#pragma unroll
                    for (int e = 0; e < 4; ++e) { const float a = acc[ai][0][m][n][e] * rs, b = acc[ai][1][m][n][e] * rs; h[n * 4 + e] = a * sigmoidf_fast(a) * b; }
                u32x4 w; w.x = cvt_pk_bf16(h[0], h[1]); w.y = cvt_pk_bf16(h[2], h[3]); w.z = cvt_pk_bf16(h[4], h[5]); w.w = cvt_pk_bf16(h[6], h[7]);
                *(u32x4*)rowp = w; }
    }
};
struct EpiRope {
    static constexpr bool FUSED = false;
    bf16_t* O; int ldc; const float* tab; const float* rstd;
    __device__ __forceinline__ void prefetch(const Unit& u, int wr, int fr, float (&rf)[2][4]) const {
        const int row0 = u.pm * BM + wr * 64 + fr;
#pragma unroll
        for (int ai = 0; ai < 2; ++ai)
#pragma unroll
            for (int m = 0; m < 4; ++m) { const f32x4 q4 = *(const f32x4*)(rstd + (size_t)(row0 + ai * HALF + m * 16) * 4); rf[ai][m] = __builtin_amdgcn_rsqf(((q4[0] + q4[1]) + (q4[2] + q4[3])) * (1.f / DM) + NORM_EPS); }
    }
    __device__ __forceinline__ void operator()(const f32x4 (&acc)[2][2][4][2], const Unit& u, int wr, int wc, int fr, int fq, const float (&rsv)[2][4]) const {
        const int row0 = u.pm * BM + wr * 64 + fr, col0 = u.pn * BM + wc * 32 + 8 * fq;
#pragma unroll
        for (int bj = 0; bj < 2; ++bj) {
            const int cw = u.pn * BM + bj * HALF + wc * 32;
            const bool rot = (cw >= 256) && (cw < 1280) && ((cw & 63) == 0);
#pragma unroll
            for (int ai = 0; ai < 2; ++ai)
#pragma unroll
                for (int m = 0; m < 4; ++m) { const int row = row0 + ai * HALF + m * 16;
                    const float rs = rsv[ai][m];
                    f32x4 v0 = acc[ai][bj][m][0] * rs, v1 = acc[ai][bj][m][1] * rs;
                    if (rot) {
                        const f32x4 c0 = *(const f32x4*)(tab + (size_t)row * 16), c1 = *(const f32x4*)(tab + (size_t)row * 16 + 4);
                        const f32x4 s0 = *(const f32x4*)(tab + (size_t)row * 16 + 8), s1 = *(const f32x4*)(tab + (size_t)row * 16 + 12);
                        f32x4 o0, o1;
#pragma unroll
                        for (int e = 0; e < 4; ++e) { o0[e] = __shfl_xor(v0[e], 16); o1[e] = __shfl_xor(v1[e], 16); }
                        const float sg = (fq == 0) ? -1.f : 1.f;
                        if (fq < 2) { v0 = v0 * c0 + (o0 * s0) * sg; v1 = v1 * c1 + (o1 * s1) * sg; }
                    }
                    u32x4 w; w.x = cvt_pk_bf16(v0[0], v0[1]); w.y = cvt_pk_bf16(v0[2], v0[3]); w.z = cvt_pk_bf16(v1[0], v1[1]); w.w = cvt_pk_bf16(v1[2], v1[3]);
                    *(u32x4*)(O + (size_t)row * ldc + col0 + bj * HALF) = w; }
        }
    }
};

struct PanelSsq {
    float* slots;
    unsigned* cnt;
    unsigned target;
    __device__ __forceinline__ void run(float (&part)[2][4], const Unit& u, int wr, int wc, int fr, int fq, LAS float* P, LAS float* S, int tid) const {
#pragma unroll
        for (int ai = 0; ai < 2; ++ai)
#pragma unroll
            for (int m = 0; m < 4; ++m) { float v = part[ai][m]; v += __shfl_xor(v, 16); v += __shfl_xor(v, 32);
                if (fq == 0) P[(ai * HALF + wr * 64 + m * 16 + fr) * 4 + wc] = v; }
        asm volatile("s_waitcnt lgkmcnt(0)" ::: "memory"); __builtin_amdgcn_s_barrier(); asm volatile("" ::: "memory");
        if (tid < 256) {
            const float sv = (P[tid * 4 + 0] + P[tid * 4 + 1]) + (P[tid * 4 + 2] + P[tid * 4 + 3]);
            __hip_atomic_store(slots + ((size_t)(u.pm * BM + tid) * 4 + u.pn), sv, __ATOMIC_RELAXED, __HIP_MEMORY_SCOPE_AGENT);
            asm volatile("s_waitcnt vmcnt(0)" ::: "memory");
            if ((tid & 63) == 0) __hip_atomic_fetch_add(cnt + 64 * u.pm, 1u, __ATOMIC_RELAXED, __HIP_MEMORY_SCOPE_AGENT);
        }
        if (tid < 64) {
            unsigned sp = 0;
            while ((unsigned)__builtin_amdgcn_readfirstlane(__hip_atomic_load(cnt + 64 * u.pm, __ATOMIC_RELAXED, __HIP_MEMORY_SCOPE_AGENT)) < target) {
                __builtin_amdgcn_s_sleep(2); if (++sp > (1u << 22)) break; }
            __builtin_amdgcn_fence(__ATOMIC_ACQUIRE, "agent");
        }
        asm volatile("s_waitcnt vmcnt(0) lgkmcnt(0)" ::: "memory"); __builtin_amdgcn_s_barrier(); asm volatile("" ::: "memory");
        if (tid < 256) {
            const float* sl = slots + (size_t)(u.pm * BM + tid) * 4;
            const float t0 = __hip_atomic_load(sl + 0, __ATOMIC_RELAXED, __HIP_MEMORY_SCOPE_AGENT), t1 = __hip_atomic_load(sl + 1, __ATOMIC_RELAXED, __HIP_MEMORY_SCOPE_AGENT);
            const float t2 = __hip_atomic_load(sl + 2, __ATOMIC_RELAXED, __HIP_MEMORY_SCOPE_AGENT), t3 = __hip_atomic_load(sl + 3, __ATOMIC_RELAXED, __HIP_MEMORY_SCOPE_AGENT);
            S[tid] = (t0 + t1) + (t2 + t3);
        }
        asm volatile("s_waitcnt vmcnt(0) lgkmcnt(0)" ::: "memory"); __builtin_amdgcn_s_barrier(); asm volatile("" ::: "memory");
    }
};
struct EpiNorm {
    static constexpr bool FUSED = true;
    bf16_t* XB; float* Fout; const float* gpost; float scale; float* ssq2; PanelSsq x1;
    __device__ __forceinline__ void prefetch(const Unit&, int, int, float (&)[2][4]) const {}
    __device__ __forceinline__ void fused(f32x4 (&acc)[2][2][4][2], const Unit& u, int wr, int wc, int fr, int fq, LAS unsigned char* xl, int tid) const {
        LAS float* P = (LAS float*)xl; LAS float* S = (LAS float*)(xl + 4096);
        const int col0 = u.pn * BM + wc * 32 + 8 * fq;
        float part[2][4];
#pragma unroll
        for (int ai = 0; ai < 2; ++ai)
#pragma unroll
            for (int m = 0; m < 4; ++m) { float q = 0.f;
#pragma unroll
                for (int bj = 0; bj < 2; ++bj)
#pragma unroll
                    for (int n = 0; n < 2; ++n) { const f32x4 v = acc[ai][bj][m][n]; q += (v[0] * v[0] + v[1] * v[1]) + (v[2] * v[2] + v[3] * v[3]); }
                part[ai][m] = q; }
        u32x4 xv[4][2];
#pragma unroll
        for (int m = 0; m < 4; ++m) { const size_t off = (size_t)(u.pm * BM + wr * 64 + m * 16 + fr) * DM + col0;
#pragma unroll
            for (int bj = 0; bj < 2; ++bj) xv[m][bj] = *(const u32x4*)(XB + off + bj * HALF); }
        x1.run(part, u, wr, wc, fr, fq, P, S, tid);
        f32x4 gp[2][2];
#pragma unroll
        for (int bj = 0; bj < 2; ++bj)
#pragma unroll
            for (int n = 0; n < 2; ++n) gp[bj][n] = *(const f32x4*)(gpost + col0 + bj * HALF + 4 * n);
#pragma unroll
        for (int ai = 0; ai < 2; ++ai)
#pragma unroll
            for (int m = 0; m < 4; ++m) { const int rl = ai * HALF + wr * 64 + m * 16 + fr; const size_t off = (size_t)(u.pm * BM + rl) * DM + col0;
                const float rs = scale * __builtin_amdgcn_rsqf(S[rl] * (1.f / DM) + NORM_EPS); float q = 0.f;
#pragma unroll
                for (int bj = 0; bj < 2; ++bj) { const u32x4 w = (ai == 0) ? xv[m][bj] : *(const u32x4*)(XB + off + bj * HALF);
                    const f32x4 x0 = (f32x4){bf_lo(w.x), bf_hi(w.x), bf_lo(w.y), bf_hi(w.y)}, x1v = (f32x4){bf_lo(w.z), bf_hi(w.z), bf_lo(w.w), bf_hi(w.w)};
                    const f32x4 n0 = x0 + acc[ai][bj][m][0] * rs * gp[bj][0], n1 = x1v + acc[ai][bj][m][1] * rs * gp[bj][1];
                    q += ((n0[0] * n0[0] + n0[1] * n0[1]) + (n0[2] * n0[2] + n0[3] * n0[3])) + ((n1[0] * n1[0] + n1[1] * n1[1]) + (n1[2] * n1[2] + n1[3] * n1[3]));
                    if (Fout) { *(f32x4*)(Fout + off + bj * HALF) = n0; *(f32x4*)(Fout + off + bj * HALF + 4) = n1; }
                    else { u32x4 o; o.x = cvt_pk_bf16(n0[0], n0[1]); o.y = cvt_pk_bf16(n0[2], n0[3]); o.z = cvt_pk_bf16(n1[0], n1[1]); o.w = cvt_pk_bf16(n1[2], n1[3]); *(u32x4*)(XB + off + bj * HALF) = o; } }
                part[ai][m] = q; }
        if (Fout) return;
#pragma unroll
        for (int ai = 0; ai < 2; ++ai)
#pragma unroll
            for (int m = 0; m < 4; ++m) { float v = part[ai][m]; v += __shfl_xor(v, 16); v += __shfl_xor(v, 32);
                if (fq == 0) P[(ai * HALF + wr * 64 + m * 16 + fr) * 4 + wc] = v; }
        asm volatile("s_waitcnt lgkmcnt(0)" ::: "memory"); __builtin_amdgcn_s_barrier(); asm volatile("" ::: "memory");
        if (tid < 256) ssq2[(size_t)(u.pm * BM + tid) * 4 + u.pn] = (P[tid * 4 + 0] + P[tid * 4 + 1]) + (P[tid * 4 + 2] + P[tid * 4 + 3]);
        asm volatile("s_waitcnt lgkmcnt(0)" ::: "memory"); __builtin_amdgcn_s_barrier(); asm volatile("" ::: "memory");
    }
};

struct GateOrder {
    StaticOrder base;
    __device__ bool next(int i, Unit& u) const { const int j = i / 3, b = i - 3 * j; if (!base.next(j, u)) return false; u.pn += 4 * b; return true; }
};
struct EpiGate {
    static constexpr bool FUSED = false;
    const bf16_t* PG; bf16_t* MRG; const float* bias; const float* rstd;
    __device__ __forceinline__ void prefetch(const Unit& u, int wr, int fr, float (&rf)[2][4]) const {
        const int row0 = u.pm * BM + wr * 64 + fr;
#pragma unroll
        for (int ai = 0; ai < 2; ++ai)
#pragma unroll
            for (int m = 0; m < 4; ++m) { const f32x4 q4 = *(const f32x4*)(rstd + (size_t)(row0 + ai * HALF + m * 16) * 4); rf[ai][m] = __builtin_amdgcn_rsqf(((q4[0] + q4[1]) + (q4[2] + q4[3])) * (1.f / DM) + NORM_EPS); }
    }
    __device__ __forceinline__ void operator()(const f32x4 (&acc)[2][2][4][2], const Unit& u, int wr, int wc, int fr, int fq, const float (&rsv)[2][4]) const {
        const int row0 = u.pm * BM + wr * 64 + fr, col0 = u.pn * BM + wc * 32 + 8 * fq, mcol0 = (u.pn & 3) * BM + wc * 32 + 8 * fq;
        const bool first = (u.pn < 4);
#pragma unroll
        for (int bj = 0; bj < 2; ++bj) {
            const f32x4 b0 = *(const f32x4*)(bias + col0 + bj * HALF), b1 = *(const f32x4*)(bias + col0 + bj * HALF + 4);
#pragma unroll
            for (int ai = 0; ai < 2; ++ai)
#pragma unroll
                for (int m = 0; m < 4; ++m) { const size_t row = (size_t)(row0 + ai * HALF + m * 16);
                    const u32x4 pv = __builtin_nontemporal_load((const u32x4*)(PG + row * 3072 + col0 + bj * HALF));
                    bf16_t* mp = MRG + row * DM + mcol0 + bj * HALF;
                    u32x4 mo = (u32x4){0u, 0u, 0u, 0u}; if (!first) mo = *(const u32x4*)mp;
                    const float rs = rsv[ai][m];
                    const f32x4 v0 = acc[ai][bj][m][0] * rs + b0, v1 = acc[ai][bj][m][1] * rs + b1;
                    const float g0 = sigmoidf_fast(v0[0]) * bf_lo(pv.x) + bf_lo(mo.x), g1 = sigmoidf_fast(v0[1]) * bf_hi(pv.x) + bf_hi(mo.x);
                    const float g2 = sigmoidf_fast(v0[2]) * bf_lo(pv.y) + bf_lo(mo.y), g3 = sigmoidf_fast(v0[3]) * bf_hi(pv.y) + bf_hi(mo.y);
                    const float g4 = sigmoidf_fast(v1[0]) * bf_lo(pv.z) + bf_lo(mo.z), g5 = sigmoidf_fast(v1[1]) * bf_hi(pv.z) + bf_hi(mo.z);
                    const float g6 = sigmoidf_fast(v1[2]) * bf_lo(pv.w) + bf_lo(mo.w), g7 = sigmoidf_fast(v1[3]) * bf_hi(pv.w) + bf_hi(mo.w);
                    u32x4 w; w.x = cvt_pk_bf16(g0, g1); w.y = cvt_pk_bf16(g2, g3); w.z = cvt_pk_bf16(g4, g5); w.w = cvt_pk_bf16(g6, g7);
                    *(u32x4*)mp = w; }
        }
    }
};

template <class Epi, bool ALIGN_EPI, class Sched>
__device__ __forceinline__ void gemm_phase(LAS unsigned char* lds, const Gemm g, const Sched& S, const Epi& E) {
    int tid = threadIdx.x; asm volatile("" : "+v"(tid));
    const int wid = __builtin_amdgcn_readfirstlane(tid >> 6), lane = tid & 63, wr = wid >> 2, wc = wid & 3, fr = lane & 15, fq = lane >> 4;
    const int nt = g.K / BK;
    unsigned voffA[2], voffB[2];
#pragma unroll
    for (int i = 0; i < 2; ++i) { int R, C; stage_rc(tid * 16 + i * 8192, R, C); const int Rb = (R & ~31) + perm32(R & 31);
        voffA[i] = (unsigned)(R * g.lda + C) * 2u; voffB[i] = (unsigned)(Rb * g.ldb + C) * 2u; }
    const size_t kstep = (size_t)(BK * 2);
    const size_t hstepA = (size_t)HALF * g.lda * 2, hstepB = (size_t)HALF * g.ldb * 2;
    const size_t tstepA = 2 * hstepA, tstepB = 2 * hstepB;
    const unsigned ldsw = (unsigned)wid * 1024u;
    const int aoff = lds_byte(wr * 64 + fr, fq * 8), boff = lds_byte(wc * 32 + fr, fq * 8);
#define PG8_SA(b, h) (((b) * 2 + (h)) * HTB)
#define PG8_SB(b, h) ((4 + (b) * 2 + (h)) * HTB)
#define PG8_STAGE(bufoff, gbase, voff) do { _Pragma("unroll") for (int _i = 0; _i < 2; ++_i) \
        __builtin_amdgcn_global_load_lds((const unsigned*)((const char*)(gbase) + (voff)[_i]), (LAS unsigned*)(lds + (bufoff) + ldsw + _i * 8192), 16, 0, 0); } while (0)
#define PG8_LDA(dst, b, h) do { _Pragma("unroll") for (int m = 0; m < 4; ++m) _Pragma("unroll") for (int k = 0; k < 2; ++k) dst[m][k] = *(const LAS bf16x8*)(lds + PG8_SA(b, h) + aoff + m * 2048 + k * 1024); } while (0)
#define PG8_LDB(dst, b, h) do { _Pragma("unroll") for (int n = 0; n < 2; ++n) _Pragma("unroll") for (int k = 0; k < 2; ++k) dst[n][k] = *(const LAS bf16x8*)(lds + PG8_SB(b, h) + boff + n * 2048 + k * 1024); } while (0)
#define PG8_MMA(ai, bj, At, Bt) do { __builtin_amdgcn_s_setprio(1); _Pragma("unroll") for (int m = 0; m < 4; ++m) _Pragma("unroll") for (int n = 0; n < 2; ++n) _Pragma("unroll") for (int k = 0; k < 2; ++k) \
        acc[ai][bj][m][n] = __builtin_amdgcn_mfma_f32_16x16x32_bf16(Bt[n][k], At[m][k], acc[ai][bj][m][n], 0, 0, 0); __builtin_amdgcn_s_setprio(0); } while (0)
#define PG8_WAIT_V(n) asm volatile("s_waitcnt vmcnt(" #n ")" ::: "memory")
#define PG8_WAIT_L(n) asm volatile("s_waitcnt lgkmcnt(" #n ")" ::: "memory")
#define PG8_BAR __builtin_amdgcn_s_barrier()
#define PG8_SCHED __builtin_amdgcn_sched_barrier(0)
    Unit cur, nxt; int ui = 0;
    if (!S.next(0, cur)) return;
    float rowf[2][4] = {}; E.prefetch(cur, wr, fr, rowf);
    f32x4 acc[2][2][4][2];
#pragma unroll
    for (int a = 0; a < 2; ++a)
#pragma unroll
        for (int b = 0; b < 2; ++b)
#pragma unroll
            for (int m = 0; m < 4; ++m)
#pragma unroll
                for (int n = 0; n < 2; ++n) acc[a][b][m][n] = (f32x4){0.f, 0.f, 0.f, 0.f};
    bf16x8 At[4][2], B0[2][2], B1[2][2];
    const char* cA = (const char*)g.A + (size_t)cur.pm * tstepA; const char* cB = (const char*)g.Bt + (size_t)cur.pn * tstepB;
    PG8_STAGE(PG8_SB(0, 0), cB, voffB); PG8_STAGE(PG8_SB(0, 1), cB + hstepB, voffB); PG8_STAGE(PG8_SA(0, 0), cA, voffA); PG8_STAGE(PG8_SA(0, 1), cA + hstepA, voffA);
    if (wr == 1) PG8_BAR;
    PG8_WAIT_V(2); PG8_BAR;
    PG8_STAGE(PG8_SB(1, 0), cB + kstep, voffB); PG8_STAGE(PG8_SA(1, 0), cA + kstep, voffA); PG8_STAGE(PG8_SB(1, 1), cB + hstepB + kstep, voffB);
    PG8_WAIT_V(6); PG8_BAR;
    for (;;) {
        const bool has_next = S.next(ui + 1, nxt);
        const char* nA = has_next ? (const char*)g.A + (size_t)nxt.pm * tstepA : cA; const char* nB = has_next ? (const char*)g.Bt + (size_t)nxt.pn * tstepB : cB;
        for (int t = 0; t < nt; t += 2) {
            const bool last = (t == nt - 2);
            const char* a1 = cA + (size_t)(t + 1) * kstep;
            const char* a2 = last ? nA : cA + (size_t)(t + 2) * kstep; const char* b2 = last ? nB : cB + (size_t)(t + 2) * kstep;
            const char* a3 = a2 + kstep; const char* b3 = b2 + kstep;
            PG8_LDB(B0, 0, 0); PG8_LDB(B1, 0, 1); PG8_SCHED; PG8_LDA(At, 0, 0); PG8_STAGE(PG8_SA(1, 1), a1 + hstepA, voffA);
            PG8_WAIT_V(8); PG8_WAIT_L(0); PG8_BAR; PG8_MMA(0, 0, At, B0); PG8_MMA(0, 1, At, B1); PG8_BAR; PG8_SCHED;
            PG8_LDA(At, 0, 1); PG8_STAGE(PG8_SB(0, 0), b2, voffB); PG8_STAGE(PG8_SB(0, 1), b2 + hstepB, voffB); PG8_STAGE(PG8_SA(0, 0), a2, voffA);
            PG8_WAIT_V(8); PG8_WAIT_L(0); PG8_BAR; PG8_MMA(1, 0, At, B0); PG8_MMA(1, 1, At, B1); PG8_BAR; PG8_SCHED;
            PG8_LDB(B0, 1, 0); PG8_LDB(B1, 1, 1); PG8_SCHED; PG8_LDA(At, 1, 0); PG8_STAGE(PG8_SA(0, 1), a2 + hstepA, voffA);
            PG8_WAIT_V(8); PG8_WAIT_L(0); PG8_BAR; PG8_MMA(0, 0, At, B0); PG8_MMA(0, 1, At, B1); PG8_BAR; PG8_SCHED;
            PG8_LDA(At, 1, 1); PG8_STAGE(PG8_SB(1, 0), b3, voffB); PG8_STAGE(PG8_SB(1, 1), b3 + hstepB, voffB); PG8_STAGE(PG8_SA(1, 0), a3, voffA);
            PG8_WAIT_V(8); PG8_WAIT_L(0); PG8_BAR; PG8_MMA(1, 0, At, B0); PG8_MMA(1, 1, At, B1); PG8_BAR; PG8_SCHED;
        }
        if constexpr (ALIGN_EPI) { if (wr == 0) PG8_BAR; }
        if constexpr (Epi::FUSED) E.fused(acc, cur, wr, wc, fr, fq, lds + STAGE_BYTES + 256, tid); else E(acc, cur, wr, wc, fr, fq, rowf);
        if (!has_next) break;
#pragma unroll
        for (int a = 0; a < 2; ++a)
#pragma unroll
            for (int b = 0; b < 2; ++b)
#pragma unroll
                for (int m = 0; m < 4; ++m)
#pragma unroll
                    for (int n = 0; n < 2; ++n) acc[a][b][m][n] = (f32x4){0.f, 0.f, 0.f, 0.f};
        cur = nxt; cA = nA; cB = nB; ++ui; E.prefetch(cur, wr, fr, rowf);
        if constexpr (ALIGN_EPI) { if (wr == 1) PG8_BAR; }
    }
    PG8_WAIT_V(0);
    if constexpr (!ALIGN_EPI) { if (wr == 0) PG8_BAR; }
    PG8_BAR;
#undef PG8_SA
#undef PG8_SB
#undef PG8_STAGE
#undef PG8_LDA
#undef PG8_LDB
#undef PG8_MMA
#undef PG8_WAIT_V
#undef PG8_WAIT_L
#undef PG8_BAR
#undef PG8_SCHED
}
}

namespace att {
#define SBAR() __builtin_amdgcn_sched_barrier(0)
#define SGB(mask, n) __builtin_amdgcn_sched_group_barrier((mask), (n), 0)
constexpr float SCALE = 0.125f;
constexpr float THR = 8.f;
constexpr int SHM_K = 64 * 64 * 2;
#define KSWZ(row, colB) ((row) * 128 + ((colB) ^ ((((row) >> 1) & 7) << 4)))
typedef __bf16 bf16x2_t __attribute__((ext_vector_type(2)));
typedef short v4i16_t __attribute__((ext_vector_type(4)));
typedef LAS const char* lds_cptr;
__device__ __forceinline__ int crow(int r, int hi) { return (r & 3) + 8 * (r >> 2) + 4 * hi; }
__device__ __forceinline__ unsigned cvtpk_s(float lo, float hi) { f32x2 v = {lo, hi}; bf16x2_t b = __builtin_convertvector(v, bf16x2_t); return __builtin_bit_cast(unsigned, b); }
__device__ __forceinline__ s16x4 vtr(lds_cptr p) { return __builtin_bit_cast(s16x4, __builtin_amdgcn_ds_read_tr16_b64_v4i16((LAS v4i16_t*)p)); }

__device__ __forceinline__ void psm_max(const f32x16& p0, const f32x16& p1, float& m_reg, float& alpha, float& mnC) {
    constexpr float C = SCALE * 1.4426950408889634f;
    float pa = fmaxf(fmaxf(p0[0], p0[1]), p1[0]), pb = fmaxf(fmaxf(p0[2], p0[3]), p1[1]); pa = fmaxf(fmaxf(pa, p1[2]), p1[3]);
#pragma unroll
    for (int r = 4; r < 16; r += 4) { pa = fmaxf(fmaxf(pa, p0[r]), p0[r + 1]); pb = fmaxf(fmaxf(pb, p0[r + 2]), p0[r + 3]); pa = fmaxf(fmaxf(pa, p1[r]), p1[r + 1]); pb = fmaxf(fmaxf(pb, p1[r + 2]), p1[r + 3]); }
    float pmax = fmaxf(pa, pb);
    { auto rr = __builtin_amdgcn_permlane32_swap(__float_as_uint(pmax), __float_as_uint(pmax), false, false);
      pmax = fmaxf(__uint_as_float(rr[0]), __uint_as_float(rr[1])); }
    const float mn = (pmax - m_reg > THR / SCALE) ? pmax : m_reg;
    alpha = __builtin_amdgcn_exp2f((m_reg - mn) * C); m_reg = mn;
    mnC = -mn * C;
}
__device__ __forceinline__ void psm_scale(f32x16& p0, f32x16& p1, float mnC) {
    constexpr float C = SCALE * 1.4426950408889634f;
#pragma unroll
    for (int r = 0; r < 16; ++r) p0[r] = fmaf(p0[r], C, mnC);
#pragma unroll
    for (int r = 0; r < 16; ++r) p1[r] = fmaf(p1[r], C, mnC);
}
template <int LO> __device__ __forceinline__ void psm_exp(f32x16& p0) {
#pragma unroll
    for (int r = LO; r < LO + 8; ++r) p0[r] = __builtin_amdgcn_exp2f(p0[r]);
}
__device__ __forceinline__ void partialSM(f32x16& p0, f32x16& p1, float& m_reg, float& alpha) {
    float mnC; psm_max(p0, p1, m_reg, alpha, mnC); psm_scale(p0, p1, mnC); psm_exp<0>(p0); psm_exp<8>(p0);
}
__device__ __forceinline__ void finishSM(f32x16& p0, f32x16& p1, float alpha, float& l_reg, bf16x8& pa0, bf16x8& pa1, bf16x8& pa2, bf16x8& pa3) {
#pragma unroll
    for (int r = 0; r < 16; ++r) p1[r] = __builtin_amdgcn_exp2f(p1[r]);
    float ps0 = 0.f, ps1 = 0.f;
#pragma unroll
    for (int r = 0; r < 16; ++r) { ps0 += p0[r]; ps1 += p1[r]; }
    float ps = ps0 + ps1;
    { auto rr = __builtin_amdgcn_permlane32_swap(__float_as_uint(ps), __float_as_uint(ps), false, false);
      ps = __uint_as_float(rr[0]) + __uint_as_float(rr[1]); }
    l_reg = l_reg * alpha + ps;
#define PK4(P, BASE, OUT) do { unsigned a0 = cvtpk_s(P[BASE + 0], P[BASE + 1]), a1 = cvtpk_s(P[BASE + 2], P[BASE + 3]);   \
    unsigned b0 = cvtpk_s(P[BASE + 4], P[BASE + 5]), b1 = cvtpk_s(P[BASE + 6], P[BASE + 7]);                              \
    auto r0 = __builtin_amdgcn_permlane32_swap(a0, b0, false, false); auto r1 = __builtin_amdgcn_permlane32_swap(a1, b1, false, false); \
    u32x4 w = {r0[0], r1[0], r0[1], r1[1]}; OUT = __builtin_bit_cast(bf16x8, w); } while (0)
    PK4(p0, 0, pa0); PK4(p0, 8, pa1); PK4(p1, 0, pa2); PK4(p1, 8, pa3);
#undef PK4
}
__device__ __forceinline__ void qkt(f32x16& p0, f32x16& p1, lds_cptr Ks, const bf16x8* qr, int r32, int hi) {
    p0 = f32x16{}; p1 = f32x16{};
    bf16x8 b0[4], b1[4];
#pragma unroll
    for (int d0 = 0; d0 < 4; ++d0) { const int cb = (d0 * 16 + hi * 8) * 2;
        b0[d0] = *reinterpret_cast<const LAS bf16x8*>(Ks + KSWZ(r32, cb));
        b1[d0] = *reinterpret_cast<const LAS bf16x8*>(Ks + KSWZ(32 + r32, cb)); }
#pragma unroll
    for (int d0 = 0; d0 < 4; ++d0) {
        p0 = __builtin_amdgcn_mfma_f32_32x32x16_bf16(b0[d0], qr[d0], p0, 0, 0, 0);
        p1 = __builtin_amdgcn_mfma_f32_32x32x16_bf16(b1[d0], qr[d0], p1, 0, 0, 0); }
}
template <int DV> __device__ __forceinline__ int v_st(int k, int c) { const int kk = (k & ~0xC) | ((k & 4) << 1) | ((k & 8) >> 1); return ((kk >> 3) * (DV / 32) + (c >> 5)) * 512 + ((kk & 7) * 32 + (c & 31)) * 2; }
__device__ __forceinline__ int v_rd_base(int lane) { return ((lane & 3) << 3) | (((lane >> 2) & 3) << 6) | (((lane >> 4) & 1) << 5) | (((lane >> 5) & 1) << 8); }
template <int DV> struct VFrag { s16x4 l[DV / 32], h[DV / 32]; };
template <int DV, int KS_IDX> __device__ __forceinline__ void v_rd(VFrag<DV>& f, lds_cptr vb) {
    constexpr int KS = DV * 32, HF = DV * 16;
#pragma unroll
    for (int d = 0; d < DV / 32; ++d) { f.l[d] = vtr(vb + d * 512 + KS_IDX * KS); f.h[d] = vtr(vb + d * 512 + KS_IDX * KS + HF); }
}
template <int DV> __device__ __forceinline__ void v_mma(f32x16* o, const VFrag<DV>& f, bf16x8 pa) {
#pragma unroll
    for (int d = 0; d < DV / 32; ++d) o[d] = __builtin_amdgcn_mfma_f32_32x32x16_bf16(pa, (bf16x8){f.l[d][0], f.l[d][1], f.l[d][2], f.l[d][3], f.h[d][0], f.h[d][1], f.h[d][2], f.h[d][3]}, o[d], 0, 0, 0);
}
template <int DV> __device__ __forceinline__ void pv_all(f32x16* o, lds_cptr vb, bf16x8 pa0, bf16x8 pa1, bf16x8 pa2, bf16x8 pa3) {
    VFrag<DV> A, B;
    v_rd<DV, 0>(A, vb); v_rd<DV, 1>(B, vb); v_mma<DV>(o, A, pa0);
    v_rd<DV, 2>(A, vb); v_mma<DV>(o, B, pa1);
    v_rd<DV, 3>(B, vb); v_mma<DV>(o, A, pa2);
    v_mma<DV>(o, B, pa3);
}
template <int DV> __device__ __forceinline__ void pv_psm(f32x16* o, lds_cptr vb, bf16x8 pa0, bf16x8 pa1, bf16x8 pa2, bf16x8 pa3, f32x16& p0, f32x16& p1, float& m_reg, float& alpha) {
    constexpr int ND = DV / 32, NV = (DV == 128) ? 8 : 16;
    VFrag<DV> A, B; float mnC;
    v_rd<DV, 0>(A, vb); SBAR();
    v_rd<DV, 1>(B, vb); v_mma<DV>(o, A, pa0); psm_max(p0, p1, m_reg, alpha, mnC);
    SGB(0x100, 2 * ND);
#pragma unroll
    for (int i = 0; i < ND; ++i) { SGB(0x008, 1); SGB(0x002, NV); }
    SBAR();
    v_rd<DV, 2>(A, vb); v_mma<DV>(o, B, pa1); psm_scale(p0, p1, mnC);
    SGB(0x100, 2 * ND);
#pragma unroll
    for (int i = 0; i < ND; ++i) { SGB(0x008, 1); SGB(0x002, NV); }
    SBAR();
    v_rd<DV, 3>(B, vb); v_mma<DV>(o, A, pa2); psm_exp<0>(p0);
    SGB(0x100, 2 * ND);
#pragma unroll
    for (int i = 0; i < ND; ++i) { SGB(0x008, 1); SGB(0x400, 8 / ND); }
    SBAR();
    v_mma<DV>(o, B, pa3); psm_exp<8>(p0);
#pragma unroll
    for (int i = 0; i < ND; ++i) { SGB(0x008, 1); SGB(0x400, 8 / ND); }
    asm volatile("" : "+v"(p0), "+v"(p1));
    SBAR();
}

template <int DV, int ldq, int ldk, int ldv>
__device__ __forceinline__ void attn_pass(const bf16_t* __restrict__ Qw, const bf16_t* __restrict__ Kh, const bf16_t* __restrict__ Vh,
                                          int NT, char* lds, f32x16 (&o)[DV / 32], float& l_out) {
    constexpr int ND = DV / 32, SHM_V = 64 * DV * 2, NVP = DV / 64;
    int tid = threadIdx.x; asm volatile("" : "+v"(tid));
    const int wid = __builtin_amdgcn_readfirstlane(tid >> 6), lane = tid & 63, r32 = lane & 31, hi = lane >> 5;
    const lds_cptr lds3 = (lds_cptr)lds;
    const lds_cptr V3 = lds3, K3 = lds3 + 4 * SHM_V;
    LAS float* al_l = (LAS float*)(lds3 + 4 * SHM_V + 4 * SHM_K) + wid * 64 + 32;
    LAS unsigned char* Vw = (LAS unsigned char*)lds3; LAS unsigned char* Kw = (LAS unsigned char*)lds3 + 4 * SHM_V;
    float m_reg = -1e30f, l_reg = 0; bf16x8 qr[4];
#pragma unroll
    for (int d = 0; d < ND; ++d) o[d] = f32x16{};
    const bf16_t* Ql = Qw + r32 * ldq + hi * 8;
#pragma unroll
    for (int d0 = 0; d0 < 4; ++d0) qr[d0] = *reinterpret_cast<const bf16x8*>(Ql + d0 * 16);
    const int krow = 8 * wid + (lane >> 3), kch = (lane & 7) ^ ((krow >> 1) & 7);
    const bf16_t* ksrc = Kh + krow * ldk + kch * 8;
    const bf16_t* vsrc[NVP];
#pragma unroll
    for (int i = 0; i < NVP; ++i) { const int p = (NVP * wid + i) * 64 + lane, st = p >> 5, kk = (st / (DV / 32)) * 8 + ((p >> 2) & 7);
        const int k = (kk & ~0xC) | ((kk & 4) << 1) | ((kk & 8) >> 1), c = (st % (DV / 32)) * 32 + (p & 3) * 8; vsrc[i] = Vh + k * ldv + c; }
    const lds_cptr vb0 = V3 + v_rd_base(lane);
#define DMA(t, slot) do { __builtin_amdgcn_global_load_lds((const unsigned*)(ksrc + (size_t)(t) * 64 * ldk), (LAS unsigned*)(Kw + (slot) * SHM_K + wid * 1024), 16, 0, 0); \
    _Pragma("unroll") for (int _i = 0; _i < NVP; ++_i) __builtin_amdgcn_global_load_lds((const unsigned*)(vsrc[_i] + (size_t)(t) * 64 * ldv), (LAS unsigned*)(Vw + (slot) * SHM_V + (NVP * wid + _i) * 1024), 16, 0, 0); } while (0)
#define RESC(a) do { if (__any((a) < 1.f)) { if (hi == 0) al_l[r32] = (a); \
    _Pragma("unroll") for (int d = 0; d < ND; ++d) _Pragma("unroll") for (int r = 0; r < 16; ++r) o[d][r] *= al_l[crow(r, hi)]; } } while (0)
#define HINT_R1() do { SGB(0x100, 8); _Pragma("unroll") for (int _i = 0; _i < 8; ++_i) { SGB(0x008, 1); SGB(0x400, 2); SGB(0x002, 10); } } while (0)
#define DRAIN_BAR() do { asm volatile("s_waitcnt vmcnt(0) lgkmcnt(0)\n\ts_barrier" ::: "memory"); } while (0)
#define COUNT_BAR() do { if constexpr (DV == 128) asm volatile("s_waitcnt vmcnt(3) lgkmcnt(0)\n\ts_barrier" ::: "memory"); else asm volatile("s_waitcnt vmcnt(2) lgkmcnt(0)\n\ts_barrier" ::: "memory"); } while (0)
    f32x16 pA0, pA1, pB0, pB1; float alA, alB; bf16x8 pa0, pa1, pa2, pa3;
    DMA(0, 0); DMA(1, 1); DMA(2, 2); DRAIN_BAR();
    qkt(pA0, pA1, K3, qr, r32, hi); partialSM(pA0, pA1, m_reg, alA);
#define BODY(Pc0, Pc1, alc, Pn0, Pn1, aln, j) do { \
        const bool more_ = ((j) + 3 < NT); \
        if (more_) DMA((j) + 3, ((j) + 3) & 3); \
        SBAR(); qkt(Pn0, Pn1, K3 + (((j) + 1) & 3) * SHM_K, qr, r32, hi); \
        finishSM(Pc0, Pc1, alc, l_reg, pa0, pa1, pa2, pa3); HINT_R1(); SBAR(); \
        pv_psm<DV>(o, vb0 + ((j) & 3) * SHM_V, pa0, pa1, pa2, pa3, Pn0, Pn1, m_reg, aln); \
        RESC(aln); if (more_) COUNT_BAR(); else DRAIN_BAR(); } while (0)
    for (int j = 0; j + 2 < NT; j += 2) {
        BODY(pA0, pA1, alA, pB0, pB1, alB, j);
        BODY(pB0, pB1, alB, pA0, pA1, alA, j + 1);
    }
    BODY(pA0, pA1, alA, pB0, pB1, alB, NT - 2);
    finishSM(pB0, pB1, alB, l_reg, pa0, pa1, pa2, pa3); SBAR();
    pv_all<DV>(o, vb0 + ((NT - 1) & 3) * SHM_V, pa0, pa1, pa2, pa3);
    l_out = l_reg;
    __syncthreads();
#undef DMA
#undef RESC
#undef HINT_R1
#undef DRAIN_BAR
#undef COUNT_BAR
#undef BODY
}
template <int DV> __device__ __forceinline__ void row_rcp(char* lds, float l_reg, float (&rli)[16]) {
    int tid = threadIdx.x; asm volatile("" : "+v"(tid));
    const int wid = tid >> 6, lane = tid & 63, r32 = lane & 31, hi = lane >> 5;
    LAS float* li_l = (LAS float*)((lds_cptr)lds + 4 * (64 * DV * 2) + 4 * SHM_K) + wid * 64;
    if (hi == 0) li_l[r32] = l_reg;
#pragma unroll
    for (int r = 0; r < 16; ++r) rli[r] = __builtin_amdgcn_rcpf(li_l[crow(r, hi)]);
}
}

struct Args { const void* in[29]; float* out; unsigned char* ws; };

struct Ctx {
    int wave, vcu, G, gw, NGW;
    unsigned char* ws;
};
__device__ __forceinline__ int opaque_tid() { int t = threadIdx.x; asm volatile("" : "+v"(t)); return t; }

__device__ __forceinline__ void transpose_item(const float* W, int N, bf16_t* WT, int ldt, int coff, int mode, LAS float* scr, int item, int lane, const float* gk = nullptr) {
    const int nblk = N / 32, kb = item / nblk, nb = item % nblk, k0 = 64 * kb, n0 = 32 * nb;
    float wv[32];
#pragma unroll
    for (int i = 0; i < 32; ++i) { const int kk = 2 * i + (lane >> 5); wv[i] = __builtin_nontemporal_load(W + (size_t)(k0 + kk) * N + n0 + (lane & 31)); }
    if (gk) {
#pragma unroll
        for (int i = 0; i < 32; ++i) wv[i] *= gk[k0 + 2 * i + (lane >> 5)]; }
#pragma unroll
    for (int i = 0; i < 32; ++i) { const int kk = 2 * i + (lane >> 5); scr[kk * 33 + (lane & 31)] = wv[i]; }
    asm volatile("s_waitcnt lgkmcnt(0)" ::: "memory");
    int d0 = n0;
    if (mode == 1) d0 = (n0 < FF) ? ((n0 >> 7) * 256 + (n0 & 127)) : (((n0 - FF) >> 7) * 256 + 128 + ((n0 - FF) & 127));
    const int c = lane & 7;
#pragma unroll
    for (int j = 0; j < 4; ++j) { const int n = (lane >> 3) + 8 * j; const LAS float* s = scr + (8 * c) * 33 + n;
        u32x4 o; o.x = cvt_pk_bf16(s[0 * 33], s[1 * 33]); o.y = cvt_pk_bf16(s[2 * 33], s[3 * 33]); o.z = cvt_pk_bf16(s[4 * 33], s[5 * 33]); o.w = cvt_pk_bf16(s[6 * 33], s[7 * 33]);
        *(u32x4*)(WT + (size_t)(d0 + n) * ldt + coff + k0 + 8 * c) = o; }
    asm volatile("s_waitcnt lgkmcnt(0)" ::: "memory");
}

__device__ __forceinline__ void convert_layer(const Ctx& C, const Args& A, LAS unsigned char* lds, int l) {
    const int lane = opaque_tid() & 63;
    LAS float* scr = (LAS float*)(lds + C.wave * 16384);
    unsigned char* wb = C.ws + WS_W;
    const float* up1 = (const float*)A.in[4] + (size_t)l * DM * NUP;  const float* dn1 = (const float*)A.in[5] + (size_t)l * FF * DM;
    const float* win = (const float*)A.in[8] + (size_t)l * DM * INW;  const float* wg = (const float*)A.in[18] + (size_t)l * DM * 3072;
    const float* brp = (const float*)A.in[20] + (size_t)l * 256 * DM; const float* brd = (const float*)A.in[21] + (size_t)l * 512 * DM;
    const float* brc = (const float*)A.in[22] + (size_t)l * 256 * DM; const float* wo = (const float*)A.in[23] + (size_t)l * DM * DM;
    const float* up2 = (const float*)A.in[26] + (size_t)l * DM * NUP; const float* dn2 = (const float*)A.in[27] + (size_t)l * FF * DM;
    const float* g_f1 = (const float*)A.in[3] + (size_t)l * DM; const float* g_mx = (const float*)A.in[7] + (size_t)l * DM; const float* g_f2 = (const float*)A.in[25] + (size_t)l * DM;
    const float* wkv = (const float*)A.in[17] + (size_t)l * DM * 512; const float* pw = (const float*)A.in[9] + (size_t)l * 4 * 64 * 64;
    constexpr int I_UP = (DM / 64) * (NUP / 32), I_DN = (FF / 64) * (DM / 32), I_IN = (DM / 64) * (INW / 32), I_G = (DM / 64) * (3072 / 32),
                  I_BP = (256 / 64) * (DM / 32), I_BD = (512 / 64) * (DM / 32), I_O = (DM / 64) * (DM / 32), I_KV = (DM / 64) * (512 / 32), I_PW = 2;
    constexpr int NITEMS = 2 * I_UP + 2 * I_DN + I_IN + I_G + 2 * I_BP + I_BD + I_O + I_KV + 4 * I_PW;
    for (int it = C.gw; it < NITEMS; it += C.NGW) {
        int r = it;
#define TR(Wp, Kk, Nn, WTo, ldt, coff, mode, NI) if (r < (NI)) { transpose_item((Wp), (Nn), (bf16_t*)(wb + (WTo)), (ldt), (coff), (mode), scr, r, lane); continue; } r -= (NI);
#define TRG(Wp, Kk, Nn, WTo, ldt, coff, mode, NI, G) if (r < (NI)) { transpose_item((Wp), (Nn), (bf16_t*)(wb + (WTo)), (ldt), (coff), (mode), scr, r, lane, (G)); continue; } r -= (NI);
        TRG(up1, DM, NUP, W_UP1, DM, 0, 1, I_UP, g_f1)
        TRG(up2, DM, NUP, W_UP2, DM, 0, 1, I_UP, g_f2)
        TR(dn1, FF, DM, W_DN1, FF, 0, 0, I_DN)
        TR(dn2, FF, DM, W_DN2, FF, 0, 0, I_DN)
        TRG(win, DM, INW, W_IN, DM, 0, 0, I_IN, g_mx)
        TRG(wg, DM, 3072, W_GATE, DM, 0, 0, I_G, g_mx)
        TR(brp, 256, DM, W_BRP, 256, 0, 0, I_BP)
        TR(brd, 512, DM, W_BRD, 512, 0, 0, I_BD)
        TR(brc, 256, DM, W_BRC, 256, 0, 0, I_BP)
        TR(wo, DM, DM, W_OUT3, DM, 0, 0, I_O)
        TR(wkv, DM, 512, W_KV, DM, 0, 0, I_KV)
        TR(pw, 64, 64, W_POOL, 64, 0, 0, I_PW)
        TR(pw + 4096, 64, 64, W_POOL + 8192, 64, 0, 0, I_PW)
        TR(pw + 8192, 64, 64, W_POOL + 16384, 64, 0, 0, I_PW)
        TR(pw + 12288, 64, 64, W_POOL + 24576, 64, 0, 0, I_PW)
#undef TR
#undef TRG
    }
    const float* mem = (const float*)A.in[1]; const float* mg = (const float*)A.in[16] + (size_t)l * DM; bf16_t* memn = (bf16_t*)(C.ws + WS_MEMN);
    for (int row = C.gw; row < NBATCH * NMEM; row += C.NGW) {
        const f32x4* xr = (const f32x4*)(mem + (size_t)row * DM) + lane; f32x4 v[4]; float ss = 0.f;
#pragma unroll
        for (int j = 0; j < 4; ++j) { v[j] = xr[64 * j]; ss += (v[j].x * v[j].x + v[j].y * v[j].y) + (v[j].z * v[j].z + v[j].w * v[j].w); }
        const float rs = __builtin_amdgcn_rsqf(wave_sum(ss) * (1.f / DM) + NORM_EPS);
#pragma unroll
        for (int j = 0; j < 4; ++j) { const f32x4 gg = *((const f32x4*)mg + lane + 64 * j); const f32x4 t = v[j] * rs * gg;
            u32x2 w; w.x = cvt_pk_bf16(t.x, t.y); w.y = cvt_pk_bf16(t.z, t.w); *((u32x2*)(memn + (size_t)row * DM) + lane + 64 * j) = w; }
    }
}

__device__ __forceinline__ void norm_phase(const Ctx& C, const float* Xf, bf16_t* XB, const bf16_t* T1, const float* gpost, float scale, float* rstd, float* Fout, bf16_t* XBo = nullptr) {
    if (XBo == nullptr) XBo = XB;
    const int lane = opaque_tid() & 63;
    for (int row0 = C.gw; row0 < NTOK; row0 += 2 * C.NGW) {
        f32x4 v[2][4]; u32x2 tw[2][4];
#pragma unroll
        for (int q = 0; q < 2; ++q) { const int row = row0 + q * C.NGW;
            if (Xf) {
#pragma unroll
                for (int j = 0; j < 4; ++j) v[q][j] = __builtin_nontemporal_load((const f32x4*)(Xf + (size_t)row * DM) + lane + 64 * j);
            } else {
#pragma unroll
                for (int j = 0; j < 4; ++j) { const u32x2 w = *((const u32x2*)(XB + (size_t)row * DM) + lane + 64 * j); v[q][j] = (f32x4){bf_lo(w.x), bf_hi(w.x), bf_lo(w.y), bf_hi(w.y)}; }
            }
            if (T1) {
#pragma unroll
                for (int j = 0; j < 4; ++j) tw[q][j] = __builtin_nontemporal_load((const u32x2*)(T1 + (size_t)row * DM) + lane + 64 * j);
            } }
#pragma unroll
        for (int q = 0; q < 2; ++q) { const int row = row0 + q * C.NGW;
            if (T1) {
                f32x4 t[4]; float ss = 0.f;
#pragma unroll
                for (int j = 0; j < 4; ++j) { const u32x2 w = tw[q][j];
                    t[j] = (f32x4){bf_lo(w.x), bf_hi(w.x), bf_lo(w.y), bf_hi(w.y)}; ss += (t[j].x * t[j].x + t[j].y * t[j].y) + (t[j].z * t[j].z + t[j].w * t[j].w); }
                const float rs = scale * __builtin_amdgcn_rsqf(wave_sum(ss) * (1.f / DM) + NORM_EPS);
#pragma unroll
                for (int j = 0; j < 4; ++j) { const f32x4 gg = *((const f32x4*)gpost + lane + 64 * j); v[q][j] = v[q][j] + t[j] * rs * gg; }
            }
            if (Fout) {
#pragma unroll
                for (int j = 0; j < 4; ++j) __builtin_nontemporal_store(v[q][j], (f32x4*)(Fout + (size_t)row * DM) + lane + 64 * j);
            } else {
                float ss = 0.f;
#pragma unroll
                for (int j = 0; j < 4; ++j) { ss += (v[q][j].x * v[q][j].x + v[q][j].y * v[q][j].y) + (v[q][j].z * v[q][j].z + v[q][j].w * v[q][j].w);
                    u32x2 w; w.x = cvt_pk_bf16(v[q][j].x, v[q][j].y); w.y = cvt_pk_bf16(v[q][j].z, v[q][j].w); *((u32x2*)(XBo + (size_t)row * DM) + lane + 64 * j) = w; }
                const float st = wave_sum(ss);
                if (lane == 0) *(f32x4*)(rstd + (size_t)row * 4) = (f32x4){st, 0.f, 0.f, 0.f};
            }
        }
    }
}

__device__ __forceinline__ void rope_table(const Ctx& C, const Args& A) {
    const int* pos = (const int*)A.in[2]; float* tab = (float*)(C.ws + WS_ROPE);
    const int tid = opaque_tid();
    for (int idx = blockIdx.x * NTHR + tid; idx < NTOK * 8; idx += C.G * NTHR) {
        const int row = idx >> 3, i = idx & 7;
        const double inv = (i == 0) ? 1.0 : (i == 1) ? 0.19392274474868576 : (i == 2) ? 0.03760603093086393 : (i == 3) ? 0.007292664737217109 :
                           (i == 4) ? 0.001414213562373095 : (i == 5) ? 0.0002742481756762073 : (i == 6) ? 5.318295896944988e-05 : 1.031338537721246e-05;
        const double rev = (double)pos[row] * inv * 0.15915494309189535;
        const float fr = (float)(rev - __builtin_rint(rev));
        tab[(size_t)row * 16 + i] = __builtin_amdgcn_cosf(fr); tab[(size_t)row * 16 + 8 + i] = __builtin_amdgcn_sinf(fr);
    }
}

template <int G>
__device__ __forceinline__ void pool_item(const bf16_t* INP, bf16_t* Y, const bf16_t* PWT, const float* pscale, int rb, int r32, int hi) {
    constexpr int W2 = 1 << G;
    const int row = rb * 32 + r32, s = row & (SEQ - 1), b0 = row - s;
    const int lo = (s - W2 < 0) ? 0 : s - W2, hi_ = (s + W2 > SEQ) ? SEQ : s + W2;
    const float rc = 1.0f / (float)(hi_ - lo);
    f32x16 a0 = f32x16{}, a1 = f32x16{};
#pragma unroll
    for (int ks = 0; ks < 4; ++ks) {
        const int ch = G * 64 + ks * 16 + hi * 8;
        u32x4 w[2 * W2];
#pragma unroll
        for (int jj = 0; jj < 2 * W2; ++jj) { int j = s - W2 + jj; j = j < 0 ? 0 : (j > SEQ - 1 ? SEQ - 1 : j); w[jj] = *(const u32x4*)(INP + (size_t)(b0 + j) * INW + ch); }
        float sum[8];
#pragma unroll
        for (int e = 0; e < 8; ++e) sum[e] = 0.f;
#pragma unroll
        for (int jj = 0; jj < 2 * W2; ++jj) { const int j = s - W2 + jj; const float m = (j >= 0 && j < SEQ) ? 1.f : 0.f;
            sum[0] += m * bf_lo(w[jj].x); sum[1] += m * bf_hi(w[jj].x); sum[2] += m * bf_lo(w[jj].y); sum[3] += m * bf_hi(w[jj].y);
            sum[4] += m * bf_lo(w[jj].z); sum[5] += m * bf_hi(w[jj].z); sum[6] += m * bf_lo(w[jj].w); sum[7] += m * bf_hi(w[jj].w); }
        const u32x4 uw = w[W2];
        const float u[8] = {bf_lo(uw.x), bf_hi(uw.x), bf_lo(uw.y), bf_hi(uw.y), bf_lo(uw.z), bf_hi(uw.z), bf_lo(uw.w), bf_hi(uw.w)};
        u32x4 pa; pa.x = cvt_pk_bf16(sum[0] * rc - u[0], sum[1] * rc - u[1]); pa.y = cvt_pk_bf16(sum[2] * rc - u[2], sum[3] * rc - u[3]);
        pa.z = cvt_pk_bf16(sum[4] * rc - u[4], sum[5] * rc - u[5]); pa.w = cvt_pk_bf16(sum[6] * rc - u[6], sum[7] * rc - u[7]);
        const bf16x8 af = *reinterpret_cast<bf16x8*>(&pa);
        const bf16x8 w0 = *reinterpret_cast<const bf16x8*>(PWT + (size_t)G * 4096 + (size_t)r32 * 64 + ks * 16 + hi * 8);
        const bf16x8 w1 = *reinterpret_cast<const bf16x8*>(PWT + (size_t)G * 4096 + (size_t)(32 + r32) * 64 + ks * 16 + hi * 8);
        a0 = __builtin_amdgcn_mfma_f32_32x32x16_bf16(af, w0, a0, 0, 0, 0);
        a1 = __builtin_amdgcn_mfma_f32_32x32x16_bf16(af, w1, a1, 0, 0, 0);
    }
    const float sc0 = pscale[G * 64 + r32], sc1 = pscale[G * 64 + 32 + r32];
#pragma unroll
    for (int r = 0; r < 16; ++r) { bf16_t* yp = Y + (size_t)(rb * 32 + att::crow(r, hi)) * DM + G * 64 + r32;
        yp[0] = (bf16_t)(cvt_pk_bf16(a0[r] * sc0, 0.f) & 0xffffu); yp[32] = (bf16_t)(cvt_pk_bf16(a1[r] * sc1, 0.f) & 0xffffu); }
}
__device__ __forceinline__ void pool_phase(const Ctx& C, const Args& A, int l) {
    const bf16_t* INP = (const bf16_t*)(C.ws + WS_BIG); bf16_t* Y = (bf16_t*)(C.ws + WS_Y);
    const bf16_t* PWT = (const bf16_t*)(C.ws + WS_W + W_POOL);
    const float* pscale = (const float*)A.in[10] + (size_t)l * 256;
    const int lane = opaque_tid() & 63, r32 = lane & 31, hi = lane >> 5;
    for (int it = C.gw, k = 0; it < (NTOK / 32) * 4; it += C.NGW, ++k) {
        const int rb = it >> 2, g = (it + k) & 3;
        if (g == 0) pool_item<0>(INP, Y, PWT, pscale, rb, r32, hi);
        else if (g == 1) pool_item<1>(INP, Y, PWT, pscale, rb, r32, hi);
        else if (g == 2) pool_item<2>(INP, Y, PWT, pscale, rb, r32, hi);
        else pool_item<3>(INP, Y, PWT, pscale, rb, r32, hi);
    }
}

__device__ __forceinline__ void da_unit(const Ctx& C, const Args& A, char* lds, int l, int b, int h, int qb, float lam) {
    const bf16_t* INP = (const bf16_t*)(C.ws + WS_BIG); bf16_t* Y = (bf16_t*)(C.ws + WS_Y);
    const size_t rowb = (size_t)b * SEQ;
    unsigned st[32];
#pragma unroll
    for (int i = 0; i < 32; ++i) st[i] = 0u;
#pragma unroll 1
    for (int c = 0; c < 2; ++c) {
        f32x16 o[4]; float l_reg; float rli[16];
        {
            const int wid0 = __builtin_amdgcn_readfirstlane(threadIdx.x >> 6);
            const size_t row0 = rowb + (size_t)qb * 256 + wid0 * 32;
            const bf16_t* Vh = INP + rowb * INW + 1280 + h * 128;
            const bf16_t* Qw = INP + row0 * INW + 256 + (h * 2 + c) * 64; const bf16_t* Kh = INP + rowb * INW + 768 + (h * 2 + c) * 64;
            att::attn_pass<128, INW, INW, INW>(Qw, Kh, Vh, SEQ / 64, lds, o, l_reg);
        }
        att::row_rcp<128>(lds, l_reg, rli);
        if (c == 0) {
#pragma unroll
            for (int d0 = 0; d0 < 4; ++d0)
#pragma unroll
                for (int r = 0; r < 16; r += 2) st[d0 * 8 + (r >> 1)] = cvt_pk_bf16(o[d0][r] * rli[r], o[d0][r + 1] * rli[r + 1]);
        } else {
            int tid = threadIdx.x; asm volatile("" : "+v"(tid));
            const int wid = tid >> 6, lane = tid & 63, r32 = lane & 31, hi = lane >> 5;
            const size_t row0 = rowb + (size_t)qb * 256 + wid * 32;
            const float* sg = (const float*)A.in[15] + (size_t)l * 128;
            const float lam_init = 0.8f - 0.6f * expf(-0.3f * (float)l);
            float gcol[4];
#pragma unroll
            for (int d0 = 0; d0 < 4; ++d0) gcol[d0] = sg[d0 * 32 + r32] * (1.0f - lam_init);
            bf16_t* Yw = Y + (row0 + 4 * hi) * DM + 256 + h * 128 + r32;
#pragma unroll
            for (int r = 0; r < 16; ++r) { float ss = 0.f; float v[4];
#pragma unroll
                for (int d0 = 0; d0 < 4; ++d0) { const unsigned w = st[d0 * 8 + (r >> 1)]; const float o0 = (r & 1) ? bf_hi(w) : bf_lo(w);
                    v[d0] = o0 - lam * (o[d0][r] * rli[r]); ss += v[d0] * v[d0]; }
#pragma unroll
                for (int off = 1; off < 32; off <<= 1) ss += __shfl_xor(ss, off);
                const float rs = __builtin_amdgcn_rsqf(ss * (1.f / 128.f) + NORM_EPS);
#pragma unroll
                for (int d0 = 0; d0 < 4; ++d0) Yw[((r & 3) + 8 * (r >> 2)) * DM + d0 * 32] = (bf16_t)(cvt_pk_bf16(v[d0] * rs * gcol[d0], 0.f) & 0xffffu);
                asm volatile("" ::: "memory"); }
        }
    }
}
__device__ __forceinline__ void ca_unit(const Ctx& C, char* lds, int b, int h, int qb) {
    const bf16_t* INP = (const bf16_t*)(C.ws + WS_BIG); bf16_t* Y = (bf16_t*)(C.ws + WS_Y); const bf16_t* KVM = (const bf16_t*)(C.ws + WS_KVM);
    const int tid = opaque_tid(), wid = tid >> 6, lane = tid & 63, r32 = lane & 31, hi = lane >> 5;
    const size_t row0 = (size_t)b * SEQ + (size_t)qb * 256 + wid * 32;
    const bf16_t* Qw = INP + row0 * INW + 1792 + h * 64;
    const bf16_t* Kh = KVM + (size_t)b * NMEM * 512 + h * 64; const bf16_t* Vh = Kh + 256;
    f32x16 o[2]; float l_reg; float rli[16];
    att::attn_pass<64, INW, 512, 512>(Qw, Kh, Vh, NMEM / 64, lds, o, l_reg);
    att::row_rcp<64>(lds, l_reg, rli);
#pragma unroll
    for (int r = 0; r < 16; ++r) { bf16_t* yp = Y + (row0 + att::crow(r, hi)) * DM + 768 + h * 64 + r32;
#pragma unroll
        for (int d0 = 0; d0 < 2; ++d0) yp[d0 * 32] = (bf16_t)(cvt_pk_bf16(o[d0][r] * rli[r], 0.f) & 0xffffu); }
}


#define XB_TMO      128
#define XB_XCNT(j)  (256  + 64 * (j))
#define XB_XSUB(j)  (1280 + 64 * (j))
#define XB_XGEN(j)  (2304 + 64 * (j))
#define XB_TOP      3328
#define XB_TOPGEN   3392
#define XCD_BAR_WORDS 3456
#define XB_SPIN_CAP (1u << 20)
__device__ __forceinline__ unsigned xb_ld(unsigned* p)              { return __hip_atomic_load(p, __ATOMIC_RELAXED, __HIP_MEMORY_SCOPE_AGENT); }
__device__ __forceinline__ unsigned xb_add(unsigned* p, unsigned v) { return __hip_atomic_fetch_add(p, v, __ATOMIC_RELAXED, __HIP_MEMORY_SCOPE_AGENT); }
__device__ __forceinline__ unsigned xb_xcc_id() { return (unsigned)__builtin_amdgcn_s_getreg((3 << 11) | 20) & 0xFu; }
#define XB_SPIN(cond, bar) do { unsigned _sp = 0; while (cond) { __builtin_amdgcn_s_sleep(1); \
    if ((++_sp & 255u) == 0u) { if (xb_ld(&(bar)[XB_TMO])) break; if (_sp > XB_SPIN_CAP) { atomicAdd(&(bar)[XB_TMO], 1u); break; } } } } while (0)
struct XcdBarrier { unsigned* bar; unsigned x; volatile LAS unsigned* st; };
__device__ __forceinline__ XcdBarrier xcd_barrier_post(unsigned* bar, volatile LAS unsigned* st) {
    XcdBarrier b; b.bar = bar; b.x = xb_xcc_id(); b.st = st;
    if (threadIdx.x == 0) (void)xb_add(&bar[XB_XCNT(b.x)], 1u);
    return b;
}
__device__ __forceinline__ void xcd_barrier_complete(unsigned* bar, unsigned x, unsigned& nloc, unsigned& nx) {
    const unsigned G = gridDim.x * gridDim.y * gridDim.z;
    unsigned sum, cnt, mine, sp = 0u;
    for (;;) {
        sum = 0u; cnt = 0u; mine = 0u;
#pragma unroll
        for (unsigned j = 0; j < 16; ++j) { const unsigned c = xb_ld(&bar[XB_XCNT(j)]); sum += c; cnt += (c > 0u) ? 1u : 0u; mine = (j == x) ? c : mine; }
        if (sum == G) break;
        __builtin_amdgcn_s_sleep(1);
        if ((++sp & 255u) == 0u) { if (xb_ld(&bar[XB_TMO])) break; if (sp > XB_SPIN_CAP) { atomicAdd(&bar[XB_TMO], 1u); break; } }
    }
    nloc = mine > 0u ? mine : 1u; nx = cnt > 0u ? cnt : 1u;
}
__device__ __forceinline__ void xcd_barrier(const XcdBarrier& b) {
    asm volatile("s_waitcnt vmcnt(0)" ::: "memory");
    __syncthreads();
    if (threadIdx.x == 0) {
        unsigned* bar = b.bar;
        __builtin_amdgcn_s_waitcnt(0);
        unsigned nloc = b.st[0], nx = b.st[1];
        if (nloc == 0u) { xcd_barrier_complete(bar, b.x, nloc, nx); b.st[0] = nloc; b.st[1] = nx; }
        const unsigned old = xb_add(&bar[XB_XSUB(b.x)], 1u);
        const unsigned gen = old / nloc;
        if (old + 1u == (gen + 1u) * nloc) {
            __builtin_amdgcn_fence(__ATOMIC_RELEASE, "agent");
            asm volatile("s_waitcnt vmcnt(0)" ::: "memory");
            const unsigned og = xb_add(&bar[XB_TOP], 1u);
            const unsigned tg = og / nx;
            if (og + 1u == (tg + 1u) * nx) xb_add(&bar[XB_TOPGEN], 1u);
            else XB_SPIN(xb_ld(&bar[XB_TOPGEN]) == tg, bar);
            __builtin_amdgcn_fence(__ATOMIC_ACQUIRE, "agent");
            xb_add(&bar[XB_XGEN(b.x)], 1u);
            asm volatile("s_waitcnt vmcnt(0)" ::: "memory");
        } else {
            XB_SPIN(xb_ld(&bar[XB_XGEN(b.x)]) == gen, bar);
            __builtin_amdgcn_fence(__ATOMIC_ACQUIRE, "agent");
            asm volatile("s_waitcnt vmcnt(0)" ::: "memory");
        }
    }
    __syncthreads();
}

constexpr int LDS_BYTES = pg8::STAGE_BYTES + 256 + 4096 + 1024;

enum { K_SWIGLU = 0, K_STORE = 1, K_NORM = 2, K_ROPE = 3, K_ATT = 4, K_GATE = 5, K_FNORM = 6, K_NONE = 7 };
constexpr int NOPS = 15;

__global__ void __launch_bounds__(NTHR) mega_fwd(Args args) {
    extern __shared__ __attribute__((aligned(16))) unsigned char lds[];
    cg::grid_group grid = cg::this_grid();
    Ctx C; C.wave = __builtin_amdgcn_readfirstlane(threadIdx.x >> 6);
    C.G = gridDim.x; { const int bx = blockIdx.x; C.vcu = (C.G % 8 == 0) ? (bx % 8) * (C.G / 8) + bx / 8 : bx; }
    C.gw = C.vcu * NWAVES + C.wave; C.NGW = C.G * NWAVES; C.ws = args.ws;
    LAS unsigned char* ldsl = (LAS unsigned char*)lds;
    unsigned char* ws = args.ws;
    bf16_t* H = (bf16_t*)(ws + WS_H); bf16_t* Y = (bf16_t*)(ws + WS_Y); bf16_t* T1 = (bf16_t*)(ws + WS_T1);
    bf16_t* BIG = (bf16_t*)(ws + WS_BIG); bf16_t* MRG = (bf16_t*)(ws + WS_MRG); bf16_t* KVM = (bf16_t*)(ws + WS_KVM); bf16_t* MEMN = (bf16_t*)(ws + WS_MEMN);
    const char* Wb = (const char*)(ws + WS_W);
    const float* x_in = (const float*)args.in[0];
    float* X = args.out;
    const int bid = (int)blockIdx.x;

    volatile LAS unsigned* bst = (volatile LAS unsigned*)(ldsl + pg8::STAGE_BYTES);
    if (threadIdx.x < 2) bst[threadIdx.x] = 0u;
    if (blockIdx.x == 0) { for (int i = threadIdx.x; i < XCD_BAR_WORDS; i += NTHR) __hip_atomic_store((unsigned*)ws + i, 0u, __ATOMIC_RELAXED, __HIP_MEMORY_SCOPE_AGENT); }
    if (blockIdx.x == 1) { for (int i = threadIdx.x; i < 128; i += NTHR) __hip_atomic_store((unsigned*)(ws + WS_XCNT) + 64 * i, 0u, __ATOMIC_RELAXED, __HIP_MEMORY_SCOPE_AGENT); }
    if (EN_CONV) convert_layer(C, args, ldsl, 0);
    if (EN_CONV) rope_table(C, args);
    float* RSTD = (float*)(ws + WS_RSTD);
    if (EN_NORM) norm_phase(C, x_in, H, nullptr, nullptr, 0.f, RSTD, nullptr);
    grid.sync();
    const XcdBarrier xbar = xcd_barrier_post((unsigned*)ws, bst);

#pragma unroll 1
    for (int step = 0; step < DEPTH * NOPS; ++step) {
        int l = step / NOPS, op = step - l * NOPS;
        asm volatile("" : "+s"(l), "+s"(op));
        int kind; bool sync = true;
        if (op == 0 || op == 12) kind = K_SWIGLU; else if (op == 3 || op == 11) kind = K_NONE; else if (op == 14) kind = K_NORM; else if (op == 4) kind = K_ROPE;
        else if (op == 5) kind = K_ATT; else if (op == 9) kind = K_GATE; else if (op == 2 || op == 10 || op == 13) kind = K_FNORM; else kind = K_STORE;
        if (op == 0 || op == 6 || op == 7 || op == 8 || op == 3 || op == 11) sync = false;
        if ((op == 13 || op == 14) && l == DEPTH - 1) sync = false;
        int reps = 1;
#if defined(PROBE_DUP_ATT)
        if (op == 5) reps = 2;
#endif
#if defined(PROBE_DUP_FFN)
        if (op == 0 || op == 2 || op == 12 || op == 13) reps = 2;
#endif
#if defined(PROBE_DUP_MIX)
        if (op == 4 || op == 6 || op == 7 || op == 8 || op == 10) reps = 2;
#endif
#pragma unroll 1
        for (int rep = 0; rep < reps; ++rep) {

        if (kind == K_SWIGLU) {
            pg8::Gemm g{H, (const bf16_t*)(Wb + (op == 0 ? W_UP1 : W_UP2)), DM, DM, NTOK, NUP, DM}; pg8::StaticOrder S; S.init(NTOK, NUP, C.G, bid);
            pg8::EpiSwiglu E{BIG, FF, RSTD}; if (EN_GEMM && EN_G1) pg8::gemm_phase<pg8::EpiSwiglu, true>(ldsl, g, S, E);
        } else if (kind == K_STORE) {
            pg8::Gemm g; pg8::EpiStore E;
            if (op == 1)       { g = pg8::Gemm{MEMN, (const bf16_t*)(Wb + W_KV), DM, DM, NBATCH * NMEM, 512, DM}; E = pg8::EpiStore{KVM, 512}; }
            else if (op == 6)  { g = pg8::Gemm{Y, (const bf16_t*)(Wb + W_BRP), DM, 256, NTOK, DM, 256}; E = pg8::EpiStore{BIG, 3072}; }
            else if (op == 7)  { g = pg8::Gemm{Y + 256, (const bf16_t*)(Wb + W_BRD), DM, 512, NTOK, DM, 512}; E = pg8::EpiStore{BIG + 1024, 3072}; }
            else               { g = pg8::Gemm{Y + 768, (const bf16_t*)(Wb + W_BRC), DM, 256, NTOK, DM, 256}; E = pg8::EpiStore{BIG + 2048, 3072}; }
            pg8::StaticOrder S; S.init(g.M, g.N, C.G, bid);
            if (EN_GEMM && EN_GS) pg8::gemm_phase<pg8::EpiStore, true>(ldsl, g, S, E);
        } else if (kind == K_ROPE) {
            pg8::Gemm g{H, (const bf16_t*)(Wb + W_IN), DM, DM, NTOK, INW, DM}; pg8::StaticOrder S; S.init(NTOK, INW, C.G, bid);
            pg8::EpiRope E{BIG, INW, (const float*)(ws + WS_ROPE), RSTD}; if (EN_GEMM && EN_GR) pg8::gemm_phase<pg8::EpiRope, true>(ldsl, g, S, E);
        } else if (kind == K_GATE) {
            pg8::Gemm g{H, (const bf16_t*)(Wb + W_GATE), DM, DM, NTOK, 3072, DM}; pg8::GateOrder S; S.base.init(NTOK, DM, C.G, bid);
            pg8::EpiGate E{BIG, MRG, (const float*)args.in[19] + (size_t)l * 3072, RSTD}; if (EN_GEMM && EN_GG) pg8::gemm_phase<pg8::EpiGate, true>(ldsl, g, S, E);
        } else if (kind == K_FNORM) {
            pg8::Gemm g;
            if (op == 2)       g = pg8::Gemm{BIG, (const bf16_t*)(Wb + W_DN1), FF, FF, NTOK, DM, FF};
            else if (op == 10) g = pg8::Gemm{MRG, (const bf16_t*)(Wb + W_OUT3), DM, DM, NTOK, DM, DM};
            else               g = pg8::Gemm{BIG, (const bf16_t*)(Wb + W_DN2), FF, FF, NTOK, DM, FF};
            const float* gpost = ((op == 2) ? (const float*)args.in[6] : (op == 10) ? (const float*)args.in[24] : (const float*)args.in[28]) + (size_t)l * DM;
            const bool last = (op == 13 && l + 1 == DEPTH);
            const unsigned seam = (unsigned)(l * 3 + (op == 2 ? 0 : op == 10 ? 1 : 2));
            pg8::PanelSsq x1{(float*)(ws + WS_XSLOT), (unsigned*)(ws + WS_XCNT), 16u * (seam + 1u)};
            pg8::EpiNorm E{H, last ? X : nullptr, gpost, (op == 10) ? 1.0f : 0.5f, RSTD, x1};
            pg8::StaticOrder S; S.init(NTOK, DM, C.G, bid);
            if (EN_GEMM) pg8::gemm_phase<pg8::EpiNorm, true>(ldsl, g, S, E);
        } else if (kind == K_NORM) {
            if (l + 1 < DEPTH) { if (EN_CONV) convert_layer(C, args, ldsl, l + 1); }
#if defined(PROBE_DUP_CONV)
            if (l + 1 < DEPTH) { convert_layer(C, args, ldsl, l + 1); convert_layer(C, args, ldsl, l + 1); }
#endif
        } else if (kind == K_NONE) {
        } else {
            const float* q1 = (const float*)args.in[11] + l * 64; const float* k1 = (const float*)args.in[12] + l * 64;
            const float* q2 = (const float*)args.in[13] + l * 64; const float* k2 = (const float*)args.in[14] + l * 64;
            const int lane_ = opaque_tid() & 63;
            float d1 = q1[lane_] * k1[lane_], d2 = q2[lane_] * k2[lane_];
            d1 = wave_sum(d1); d2 = wave_sum(d2);
            const float lam = __uint_as_float(__builtin_amdgcn_readfirstlane(__float_as_uint(expf(d1) - expf(d2) + (0.8f - 0.6f * expf(-0.3f * (float)l)))));
#pragma unroll 1
            for (int i = 0; i < 2; ++i) { const int u = C.vcu * 2 + i; if (EN_DA && u < NBATCH * 4 * 32) da_unit(C, args, (char*)lds, l, u >> 7, (u >> 5) & 3, u & 31, lam); }
#pragma unroll 1
            for (int i = 0; i < 2; ++i) { const int u = C.vcu * 2 + i; if (EN_CA && u < NBATCH * 4 * 32) ca_unit(C, (char*)lds, u >> 7, (u >> 5) & 3, u & 31); }
            if (EN_POOL) pool_phase(C, args, l);
        }
        }
        if (sync) xcd_barrier(xbar);
#if defined(PROBE_DUP_SYNC)
        if (sync) { xcd_barrier(xbar); xcd_barrier(xbar); xcd_barrier(xbar); xcd_barrier(xbar); }
#endif
    }
}

extern "C" void kernel_launch(void* const* d_in, const int* in_sizes, int n_in, void* d_out, int out_size, void* d_ws, size_t ws_size, hipStream_t stream) {
    static int grid = 0;
    if (grid == 0) {
        if (n_in != 29 || in_sizes[0] != NTOK * DM || out_size != NTOK * DM || ws_size < WS_TOTAL) {
            fprintf(stderr, "kernel_launch: unexpected shapes: n_in %d in0 %d out %d ws %zu (need %zu)\n", n_in, n_in > 0 ? in_sizes[0] : -1, out_size, ws_size, (size_t)WS_TOTAL); grid = -1; return; }
        int dev = 0, cus = 0, per_cu = 0;
        hipGetDevice(&dev); hipDeviceGetAttribute(&cus, hipDeviceAttributeMultiprocessorCount, dev);
        if (hipFuncSetAttribute((const void*)mega_fwd, hipFuncAttributeMaxDynamicSharedMemorySize, LDS_BYTES) != hipSuccess) { fprintf(stderr, "kernel_launch: hipFuncSetAttribute failed\n"); grid = -1; return; }
        if (hipOccupancyMaxActiveBlocksPerMultiprocessor(&per_cu, (const void*)mega_fwd, NTHR, LDS_BYTES) != hipSuccess || per_cu < 1) { fprintf(stderr, "kernel_launch: occupancy query says %d\n", per_cu); per_cu = 1; }
        (void)hipGetLastError();
        grid = cus;
        fprintf(stderr, "kernel_launch: grid %d (cus %d, per_cu %d)\n", grid, cus, per_cu);
    }
    if (grid < 0) return;
    Args a{};
    for (int i = 0; i < 29; ++i) a.in[i] = d_in[i];
    a.out = (float*)d_out; a.ws = (unsigned char*)d_ws;
    void* kargs[] = {&a};
    hipError_t e = hipLaunchCooperativeKernel((const void*)mega_fwd, dim3(grid), dim3(NTHR), kargs, LDS_BYTES, stream);
    if (e != hipSuccess) fprintf(stderr, "kernel_launch: cooperative launch failed: %s (grid %d)\n", hipGetErrorString(e), grid);
}
```
